# Optimizing an MI355X kernel written in HIP

```python
import math
import jax, jax.numpy as jnp
from jax import lax
import numpy as np

D_MODEL = 2048
BATCH = 2
SEQ = 8192
DEPTH = 2

GRID_W = 64
CTX_LEN = 256
DIFF_DQK = 64
DIFF_DV = 2 * DIFF_DQK
DIFF_HEADS = D_MODEL // (2 * DIFF_DV)
GLA_DV = 128
GLA_DK = GLA_DV // 2
GLA_HEADS = D_MODEL // (4 * GLA_DV)
GLA_RANK = 16
GLA_TAU = 16.0
GLA_CHUNK = 64
FOURIER_W = D_MODEL // 4
FOURIER_DG = 128
FOURIER_GROUPS = FOURIER_W // FOURIER_DG
MIX_W = DIFF_HEADS * DIFF_DV + GLA_HEADS * GLA_DV + FOURIER_W
D_FF = 4 * D_MODEL
Q_BLOCK = 128
ROPE_BASE = 10000.0
EPS = 1e-6
SPLIT_SIZES = (DIFF_HEADS * 2 * DIFF_DQK, DIFF_HEADS * 2 * DIFF_DQK, DIFF_HEADS * DIFF_DV,
               GLA_HEADS * GLA_DK, GLA_HEADS * GLA_DK, GLA_HEADS * GLA_DV, GLA_HEADS * GLA_DV,
               2 * GLA_RANK, FOURIER_W)
SPLIT_POINTS = tuple(int(v) for v in np.cumsum(SPLIT_SIZES)[:-1])
D_IN = int(sum(SPLIT_SIZES))

kernel_name = 'hybrid_diffattn_gla_fourier_dit'


def rms_norm(x, g):
    xf = x.astype(jnp.float32)
    y = xf * lax.rsqrt(jnp.mean(xf * xf, axis=-1, keepdims=True) + EPS)
    return (y * g.astype(jnp.float32)).astype(x.dtype)


def modulate(h, g, shift, scale):
    return rms_norm(h, g) * (1.0 + scale[:, None, :]) + shift[:, None, :]


def rope_axis(x, pos):
    half = x.shape[-1] // 2
    inv = ROPE_BASE ** (-jnp.arange(half, dtype=jnp.float32) / half)
    ang = pos.astype(jnp.float32)[:, None] * inv[None, :]
    cos = jnp.cos(ang)[None, :, None, None, :]
    sin = jnp.sin(ang)[None, :, None, None, :]
    x1, x2 = x[..., :half], x[..., half:]
    return jnp.concatenate([x1 * cos - x2 * sin, x2 * cos + x1 * sin], axis=-1).astype(x.dtype)


def rope_2d(x, rows, cols):
    h = x.shape[-1] // 2
    return jnp.concatenate([rope_axis(x[..., :h], rows), rope_axis(x[..., h:], cols)], axis=-1)


def diff_qkv(pq, pk, pv, qg, kg, rows, cols):
    b, n = pq.shape[:2]
    q = rms_norm(pq.reshape(b, n, DIFF_HEADS, 2, DIFF_DQK), qg)
    k = rms_norm(pk.reshape(b, n, DIFF_HEADS, 2, DIFF_DQK), kg)
    if rows is not None:
        q = rope_2d(q, rows, cols)
        k = rope_2d(k, rows, cols)
    v = pv.reshape(b, n, DIFF_HEADS, DIFF_DV)
    return q, k, v


def diff_attn_core(q, k, v, lam):
    s = jnp.einsum('bqhmd,bkhmd->bhmqk', q, k).astype(jnp.float32) * (DIFF_DQK ** -0.5)
    p = jax.nn.softmax(s, axis=-1)
    w = p[:, :, 0] - lam * p[:, :, 1]
    return jnp.einsum('bhqk,bkhe->bqhe', w.astype(v.dtype), v)


def diff_attn_blocked(q, k, v, lam):
    b, n = q.shape[:2]
    nb = n // Q_BLOCK
    qb = q.reshape(b, nb, Q_BLOCK, *q.shape[2:]).swapaxes(0, 1)
    ob = lax.map(lambda qq: diff_attn_core(qq, k, v, lam), qb)
    return ob.swapaxes(0, 1).reshape(b, n, DIFF_HEADS, DIFF_DV)


def diff_post(o, g, lam_init):
    b, n = o.shape[:2]
    return (rms_norm(o, g) * (1.0 - lam_init)).reshape(b, n, DIFF_HEADS * DIFF_DV)


def to_chunks(t):
    b, n, h, d = t.shape
    return t.reshape(b, n // GLA_CHUNK, GLA_CHUNK, h, d).transpose(0, 3, 1, 2, 4)


def from_chunks(t):
    b, h, nc, cl, d = t.shape
    return t.transpose(0, 2, 3, 1, 4).reshape(b, nc * cl, h, d)


def gla_states(k, v, g, s0):
    b = jnp.cumsum(g, axis=3)
    b_last = b[:, :, :, -1:, :]
    kv = jnp.einsum('bhncd,bhnce->bhnde', k * jnp.exp(b_last - b), v)
    decay = jnp.exp(b_last[:, :, :, 0, :])

    def step(s, inp):
        dec, kv_n = inp
        return dec[..., None] * s + kv_n, s

    s_final, s_before = lax.scan(step, s0, (jnp.moveaxis(decay, 2, 0), jnp.moveaxis(kv, 2, 0)))
    return s_final, jnp.moveaxis(s_before, 0, 2)


def gla_outputs(q, k, v, g, s_before):
    b = jnp.cumsum(g, axis=3)
    q_e = q * jnp.exp(b) * (GLA_DK ** -0.5)
    k_e = k * jnp.exp(-b)
    mask = jnp.tril(jnp.ones((GLA_CHUNK, GLA_CHUNK), dtype=bool))
    att = jnp.where(mask, jnp.einsum('bhncd,bhnmd->bhncm', q_e, k_e), 0.0)
    return (jnp.einsum('bhncd,bhnde->bhnce', q_e, s_before)
            + jnp.einsum('bhncm,bhnme->bhnce', att, v))


def gla_bidirectional(ctx_parts, lat_parts, w_up, b_up, need_ctx):
    lat_outs, ctx_outs = [], []
    for d in range(2):
        def orient(t):
            return jnp.flip(t, axis=1) if d == 1 else t

        def prep(pq, pk, pv, pa):
            b_, n = pq.shape[:2]
            q = pq.reshape(b_, n, GLA_HEADS, GLA_DK)
            k = pk.reshape(b_, n, GLA_HEADS, GLA_DK)
            v = pv.reshape(b_, n, GLA_HEADS, GLA_DV)
            z = (jnp.einsum('bnr,rk->bnk', pa[..., d * GLA_RANK:(d + 1) * GLA_RANK], w_up[d]).astype(jnp.float32)
                 + b_up[d].astype(jnp.float32))
            g = (jax.nn.log_sigmoid(z) / GLA_TAU).reshape(b_, n, GLA_HEADS, GLA_DK)
            return tuple(to_chunks(orient(t)) for t in (q, k, v, g))

        qc, kc, vc, gc = prep(*ctx_parts)
        ql, kl, vl, gl = prep(*lat_parts)
        s0 = jnp.zeros((kc.shape[0], GLA_HEADS, GLA_DK, GLA_DV), jnp.float32)
        s_ctx, sb_ctx = gla_states(kc, vc, gc, s0)
        _, sb_lat = gla_states(kl, vl, gl, s_ctx)
        lat_outs.append(orient(from_chunks(gla_outputs(ql, kl, vl, gl, sb_lat))))
        if need_ctx:
            ctx_outs.append(orient(from_chunks(gla_outputs(qc, kc, vc, gc, sb_ctx))))
    o_ctx = ctx_outs[0] + ctx_outs[1] if need_ctx else None
    return lat_outs[0] + lat_outs[1], o_ctx


def gla_post(o, r, g):
    b, n = r.shape[:2]
    gate = jax.nn.silu(r.reshape(b, n, GLA_HEADS, GLA_DV).astype(jnp.float32))
    return (rms_norm(o, g) * gate).reshape(b, n, GLA_HEADS * GLA_DV).astype(r.dtype)


def fourier_mix(u, w_f):
    b, n = u.shape[:2]
    uf = u.astype(jnp.float32).reshape(b, n, FOURIER_GROUPS, FOURIER_DG)
    y = jnp.fft.fft2(uf, axes=(1, 3), norm='ortho').real
    return y.reshape(b, n, FOURIER_W).astype(u.dtype) @ w_f


def ffn(h, g, sh, sc, w1, w2):
    hm = modulate(h, g, sh, sc)
    return jnp.square(jax.nn.relu(hm @ w1)) @ w2


def setup_inputs(seed: int = 0) -> dict:
    key = jax.random.key(seed)
    ks = jax.random.split(key, 24)
    f32 = jnp.float32

    def nrm(k, shape, scale):
        return jax.random.normal(k, shape, f32) * scale

    return {
        'x': nrm(ks[0], (BATCH, SEQ, D_MODEL), 1.0),
        'c': nrm(ks[1], (BATCH, D_MODEL), 1.0),
        'ctx': nrm(ks[2], (BATCH, CTX_LEN, D_MODEL), 1.0),
        'c_ctx': nrm(ks[3], (D_MODEL,), 1.0),
        'w_mod': nrm(ks[4], (DEPTH, D_MODEL, 6 * D_MODEL), D_MODEL ** -0.5),
        'b_mod': nrm(ks[5], (DEPTH, 6 * D_MODEL), 0.02),
        'norm1_g': 1.0 + nrm(ks[6], (DEPTH, D_MODEL), 0.02),
        'norm2_g': 1.0 + nrm(ks[7], (DEPTH, D_MODEL), 0.02),
        'w_in': nrm(ks[8], (DEPTH, D_MODEL, D_IN), D_MODEL ** -0.5),
        'q_norm_g': 1.0 + nrm(ks[9], (DEPTH, DIFF_DQK), 0.02),
        'k_norm_g': 1.0 + nrm(ks[10], (DEPTH, DIFF_DQK), 0.02),
        'diff_lambda': nrm(ks[11], (DEPTH, 4, DIFF_DQK), 0.1),
        'diff_subln_g': 1.0 + nrm(ks[12], (DEPTH, DIFF_DV), 0.02),
        'gla_w_up': nrm(ks[13], (DEPTH, 2, GLA_RANK, GLA_HEADS * GLA_DK), GLA_RANK ** -0.5),
        'gla_b_up': nrm(ks[14], (DEPTH, 2, GLA_HEADS * GLA_DK), 0.1),
        'gla_norm_g': 1.0 + nrm(ks[15], (DEPTH, GLA_DV), 0.02),
        'w_fourier': nrm(ks[16], (DEPTH, FOURIER_W, FOURIER_W), FOURIER_W ** -0.5),
        'w_out': nrm(ks[17], (DEPTH, MIX_W, D_MODEL), MIX_W ** -0.5),
        'w_ff1': nrm(ks[18], (DEPTH, D_MODEL, D_FF), D_MODEL ** -0.5),
        'w_ff2': nrm(ks[19], (DEPTH, D_FF, D_MODEL), D_FF ** -0.5),
    }


def reference(x, c, ctx, c_ctx, w_mod, b_mod, norm1_g, norm2_g, w_in, q_norm_g, k_norm_g,
              diff_lambda, diff_subln_g, gla_w_up, gla_b_up, gla_norm_g, w_fourier, w_out, w_ff1, w_ff2):
    n_tok = x.shape[1]
    rows_n = n_tok // GRID_W
    rows = jnp.repeat(jnp.arange(rows_n), GRID_W)
    cols = jnp.arange(n_tok) % GRID_W
    silu_lat = jax.nn.silu(c)
    silu_ctx = jax.nn.silu(c_ctx)[None, :]
    h_lat, h_ctx = x, ctx
    for l in range(DEPTH):
        last = l == DEPTH - 1
        sh1, sc1, gt1, sh2, sc2, gt2 = jnp.split(silu_lat @ w_mod[l] + b_mod[l], 6, axis=-1)
        csh1, csc1, cgt1, csh2, csc2, cgt2 = jnp.split(silu_ctx @ w_mod[l] + b_mod[l], 6, axis=-1)

        pl = jnp.split(modulate(h_lat, norm1_g[l], sh1, sc1) @ w_in[l], SPLIT_POINTS, axis=-1)
        pc = jnp.split(modulate(h_ctx, norm1_g[l], csh1, csc1) @ w_in[l], SPLIT_POINTS, axis=-1)

        lam_init = 0.8 - 0.6 * math.exp(-0.3 * l)
        lam_p = diff_lambda[l].astype(jnp.float32)
        lam = jnp.exp(jnp.sum(lam_p[0] * lam_p[1])) - jnp.exp(jnp.sum(lam_p[2] * lam_p[3])) + lam_init
        ql, kl, vl = diff_qkv(pl[0], pl[1], pl[2], q_norm_g[l], k_norm_g[l], rows, cols)
        qc, kc, vc = diff_qkv(pc[0], pc[1], pc[2], q_norm_g[l], k_norm_g[l], None, None)
        k_all = jnp.concatenate([kc, kl], axis=1)
        v_all = jnp.concatenate([vc, vl], axis=1)
        a_lat = diff_post(diff_attn_blocked(ql, k_all, v_all, lam), diff_subln_g[l], lam_init)

        o_lat, o_ctx = gla_bidirectional((pc[3], pc[4], pc[5], pc[7]), (pl[3], pl[4], pl[5], pl[7]),
                                         gla_w_up[l], gla_b_up[l], not last)
        b_lat = gla_post(o_lat, pl[6], gla_norm_g[l])

        f_lat = fourier_mix(pl[8], w_fourier[l])

        y_lat = jnp.concatenate([a_lat, b_lat, f_lat], axis=-1) @ w_out[l]
        new_lat = h_lat + gt1[:, None, :] * y_lat
        new_lat = new_lat + gt2[:, None, :] * ffn(new_lat, norm2_g[l], sh2, sc2, w_ff1[l], w_ff2[l])

        if not last:
            a_ctx = diff_post(diff_attn_core(qc, kc, vc, lam), diff_subln_g[l], lam_init)
            b_ctx = gla_post(o_ctx, pc[6], gla_norm_g[l])
            f_ctx = fourier_mix(pc[8], w_fourier[l])
            y_ctx = jnp.concatenate([a_ctx, b_ctx, f_ctx], axis=-1) @ w_out[l]
            new_ctx = h_ctx + cgt1[:, None, :] * y_ctx
            h_ctx = new_ctx + cgt2[:, None, :] * ffn(new_ctx, norm2_g[l], csh2, csc2, w_ff1[l], w_ff2[l])
        h_lat = new_lat
    return h_lat
```

```cpp
#include <hip/hip_runtime.h>
#include <hip/hip_cooperative_groups.h>
#include <cstdio>
#include <cstdint>
namespace cg = cooperative_groups;

#define LAS __attribute__((address_space(3)))
typedef unsigned short bf16_t;
typedef short bf16x8 __attribute__((ext_vector_type(8)));
typedef float f32x4 __attribute__((ext_vector_type(4)));
typedef float f32x16 __attribute__((ext_vector_type(16)));
typedef unsigned u32x4 __attribute__((ext_vector_type(4)));
typedef unsigned u32x2 __attribute__((ext_vector_type(2)));
#define DI __device__ __forceinline__
#define LDS_WAIT() asm volatile("s_waitcnt lgkmcnt(0)" ::: "memory")

constexpr int DM = 2048, NB = 2, SEQ = 8192, CTXL = 256, TPB = SEQ + CTXL  , MROWS = NB * TPB  ;
constexpr int DIN = 5152, NIN = 5376, DFF = 8192, P2W = 2304, NCH = TPB / 64  ;
constexpr float EPS = 1e-6f;
constexpr float QSCALE = 0.18033688011112042f;
constexpr float LOG2E = 1.4426950408889634f;

constexpr size_t al256(size_t x) { return (x + 255) & ~(size_t)255; }
constexpr size_t WS_MOD = 0;
constexpr size_t WS_XC = al256(WS_MOD + (size_t)2 * 3 * 12288 * 4);
constexpr size_t WS_WIN = al256(WS_XC + (size_t)512 * DM * 4);
constexpr size_t WS_WOUT = al256(WS_WIN + (size_t)NIN * DM * 2);
constexpr size_t WS_WFF1 = al256(WS_WOUT + (size_t)DM * DM * 2);
constexpr size_t WS_WFF2 = al256(WS_WFF1 + (size_t)DFF * DM * 2);
constexpr size_t WS_WCS = al256(WS_WFF2 + (size_t)DM * DFF * 2);
constexpr size_t WS_TCTX = al256(WS_WCS + (size_t)512 * 1024 * 2);
constexpr size_t WS_A = al256(WS_TCTX + (size_t)512 * 256 * 2);
constexpr size_t WS_QB = al256(WS_A + (size_t)MROWS * DM * 2);
constexpr size_t WS_KB = al256(WS_QB + (size_t)MROWS * 1024 * 2);
constexpr size_t WS_VB = al256(WS_KB + (size_t)MROWS * 1024 * 2);
constexpr size_t WS_VT = al256(WS_VB + (size_t)MROWS * 1024 * 2);
constexpr size_t WS_P2 = al256(WS_VT + (size_t)MROWS * 1024 * 2);
constexpr size_t WS_T = al256(WS_P2 + (size_t)MROWS * P2W * 2);
constexpr size_t WS_B2T = WS_T;
constexpr size_t WS_A1 = WS_T + ((size_t)100 << 20);
constexpr size_t WS_A2 = WS_A1 + 65536;
constexpr size_t WS_H = WS_QB;
constexpr size_t WS_UTL = al256(WS_T + (size_t)8448 * 8192 * 2);
constexpr size_t WS_UTC = al256(WS_UTL + (size_t)1024 * 8192 * 2);
constexpr size_t WS_PQ = al256(WS_UTC + (size_t)1024 * 256 * 2);
constexpr size_t WS_KV = al256(WS_PQ + (size_t)MROWS * 1024 * 2);
constexpr size_t WS_DEC = al256(WS_KV + (size_t)16 * NCH * 8192 * 4);
constexpr size_t WS_PART = al256(WS_DEC + (size_t)16 * NCH * 64 * 4);
constexpr size_t WS_BAR = al256(WS_PART + (size_t)8 * 512 * DM * 4);
constexpr size_t WS_END = WS_BAR + 16384;
constexpr int NSPLIT = 8;
static_assert(WS_H + (size_t)MROWS * DFF * 2 <= WS_UTL, "H overlay must end before UTL");
static_assert(WS_KB - WS_QB == (size_t)MROWS * 2048 && WS_VB - WS_KB == (size_t)MROWS * 2048 && WS_P2 - WS_QB == 4 * (size_t)MROWS * 2048, "in-proj destinations at fixed strides");

constexpr int LDS_BYTES = 160768;
#ifndef REPK
#define REPK -1
#endif
#define NREP(k) ((l == 0 && (k) == REPK) ? 2 : 1)

DI unsigned f2bf(float f) { unsigned u = __builtin_bit_cast(unsigned, f); return (u + 0x7fffu + ((u >> 16) & 1u)) >> 16; }
DI unsigned pk2(float lo, float hi) { return f2bf(lo) | (f2bf(hi) << 16); }
DI float bf2f(unsigned h) { return __builtin_bit_cast(float, h << 16); }
DI unsigned cvt_pk_bf16(float lo, float hi) { unsigned r; asm volatile("v_cvt_pk_bf16_f32 %0, %1, %2" : "=v"(r) : "v"(lo), "v"(hi)); return r; }
DI int TID() { int t = threadIdx.x; asm volatile("" : "+v"(t)); return t; }
DI int BID() { int t = blockIdx.x; asm volatile("" : "+s"(t)); return t; }
DI int GDIM() { int t = gridDim.x; asm volatile("" : "+s"(t)); return t; }
template <class T> DI T* LP(T* p) { asm volatile("" : "+s"(p)); return p; }
DI float wave_sum(float v) {
#pragma unroll
    for (int o = 1; o < 64; o <<= 1) v += __shfl_xor(v, o);
    return v;
}
DI float logsig(float z) { return fminf(z, 0.f) - __logf(1.f + __expf(-fabsf(z))); }

namespace pg8 {
constexpr int BM = 256, BK = 64, HALF = 128, HTB = HALF * BK * 2, STAGE_BYTES = 8 * HTB, NXCD = 8, WGM = 8;
DI int lds_byte(int r, int c) { const int st = (r >> 4) * 2 + (c >> 5), rr = r & 15, cc = c & 31, ob = rr * 64 + cc * 2; return st * 1024 + (ob ^ (((ob >> 9) & 1) << 5)); }
DI void stage_rc(int b, int& R, int& C) { const int st = b / 1024, sb = b % 1024, swz = sb ^ (((sb >> 9) & 1) << 5); R = (st >> 1) * 16 + swz / 64; C = (st & 1) * 32 + (swz % 64) / 2; }
DI int perm32(int rho) { const int n = rho >> 4, i = rho & 15; return 8 * (i >> 2) + 4 * n + (i & 3); }
struct Unit { int pm, pn, ko; };
struct Gemm { const bf16_t* A; const bf16_t* Bt; int K, lda, ldb; };
struct Order {
    int nM, nN, nwg, G, c, skip, nK, ksub;
    DI void init(int nM_, int nN_, int G_, int c_, int skip_, int nK_ = 1, int ksub_ = 0) { nM = nM_; nN = nN_; nwg = nM * nN; G = G_; c = c_; skip = skip_; nK = nK_; ksub = ksub_; }
    DI bool next(int i, Unit& u) const {
        if (c < 0 || c >= G) return false;
        const int L = i * G + c; if (L >= nwg * nK) return false;
        int wgid = L % nwg; u.ko = (L / nwg) * ksub;
        { const int q = nwg / NXCD, r = nwg % NXCD, xcd = wgid % NXCD, off = wgid / NXCD; wgid = (xcd < r ? xcd * (q + 1) : r * (q + 1) + (xcd - r) * q) + off; }
        const int nig = WGM * nN, gid = wgid / nig, fm = gid * WGM, gsz = (nM - fm) < WGM ? (nM - fm) : WGM;
        int pm = fm + ((wgid % nig) % gsz); u.pn = (wgid % nig) / gsz;
        if (skip == 1) pm = pm + 1 + (pm >= 32 ? 1 : 0);
        if (skip == 2) pm = pm * 33;
        u.pm = pm; return true;
    }
};

template <class Epi>
DI void gemm_phase(LAS unsigned char* lds, const Gemm g, const Order& S, const Epi& E) {
    const int tid = TID(), wid = __builtin_amdgcn_readfirstlane(tid >> 6), lane = tid & 63, wr = wid >> 2, wc = wid & 3, fr = lane & 15, fq = lane >> 4;
    int K = g.K; asm volatile("" : "+s"(K));
    const int nt = K / BK;
    unsigned voffA[2], voffB[2];
#pragma unroll
    for (int i = 0; i < 2; ++i) { int R, C; stage_rc(tid * 16 + i * 8192, R, C); const int Rb = Epi::PERM ? ((R & ~31) + perm32(R & 31)) : R;
        voffA[i] = (unsigned)(R * g.lda + C) * 2u; voffB[i] = (unsigned)(Rb * g.ldb + C) * 2u; }
    const size_t kstep = (size_t)(BK * 2);
    const size_t hstepA = (size_t)HALF * g.lda * 2, hstepB = (size_t)HALF * g.ldb * 2;
    const size_t tstepA = 2 * hstepA, tstepB = 2 * hstepB;
    const unsigned ldsw = (unsigned)wid * 1024u;
    const int aoff = lds_byte(wr * 64 + fr, fq * 8), boff = lds_byte(wc * 32 + fr, fq * 8);
#define PG8_SA(b, h) (((b) * 2 + (h)) * HTB)
#define PG8_SB(b, h) ((4 + (b) * 2 + (h)) * HTB)
#define PG8_STAGE(bufoff, gbase, voff) do { _Pragma("unroll") for (int _i = 0; _i < 2; ++_i) \
        __builtin_amdgcn_global_load_lds((const unsigned*)((const char*)(gbase) + (voff)[_i]), (LAS unsigned*)(lds + (bufoff) + ldsw + _i * 8192), 16, 0, 0); } while (0)
#define PG8_LDA(dst, b, h) do { _Pragma("unroll") for (int m = 0; m < 4; ++m) _Pragma("unroll") for (int k = 0; k < 2; ++k) dst[m][k] = *(const LAS bf16x8*)(lds + PG8_SA(b, h) + aoff + m * 2048 + k * 1024); } while (0)
#define PG8_LDB(dst, b, h) do { _Pragma("unroll") for (int n = 0; n < 2; ++n) _Pragma("unroll") for (int k = 0; k < 2; ++k) dst[n][k] = *(const LAS bf16x8*)(lds + PG8_SB(b, h) + boff + n * 2048 + k * 1024); } while (0)
#define PG8_MMA(ai, bj, At, Bt) do { __builtin_amdgcn_s_setprio(1); _Pragma("unroll") for (int m = 0; m < 4; ++m) _Pragma("unroll") for (int n = 0; n < 2; ++n) _Pragma("unroll") for (int k = 0; k < 2; ++k) \
        acc[ai][bj][m][n] = __builtin_amdgcn_mfma_f32_16x16x32_bf16(Bt[n][k], At[m][k], acc[ai][bj][m][n], 0, 0, 0); __builtin_amdgcn_s_setprio(0); } while (0)
#define PG8_WAIT_V(n) asm volatile("s_waitcnt vmcnt(" #n ")" ::: "memory")
#define PG8_WAIT_L(n) asm volatile("s_waitcnt lgkmcnt(" #n ")" ::: "memory")
#define PG8_BAR __builtin_amdgcn_s_barrier()
#define PG8_SCHED __builtin_amdgcn_sched_barrier(0)
    Unit cur, nxt; int ui = 0;
    if (!S.next(0, cur)) return;
    f32x4 acc[2][2][4][2];
#pragma unroll
    for (int a = 0; a < 2; ++a)
#pragma unroll
        for (int b = 0; b < 2; ++b)
#pragma unroll
            for (int m = 0; m < 4; ++m)
#pragma unroll
                for (int n = 0; n < 2; ++n) acc[a][b][m][n] = (f32x4){0.f, 0.f, 0.f, 0.f};
    bf16x8 At[4][2], B0[2][2], B1[2][2];
    const char* cA = (const char*)g.A + (size_t)cur.pm * tstepA + (size_t)cur.ko * 2; const char* cB = (const char*)g.Bt + (size_t)cur.pn * tstepB + (size_t)cur.ko * 2;
    PG8_STAGE(PG8_SB(0, 0), cB, voffB); PG8_STAGE(PG8_SB(0, 1), cB + hstepB, voffB); PG8_STAGE(PG8_SA(0, 0), cA, voffA); PG8_STAGE(PG8_SA(0, 1), cA + hstepA, voffA);
    if (wr == 1) PG8_BAR;
    PG8_WAIT_V(2); PG8_BAR;
    PG8_STAGE(PG8_SB(1, 0), cB + kstep, voffB); PG8_STAGE(PG8_SA(1, 0), cA + kstep, voffA); PG8_STAGE(PG8_SB(1, 1), cB + hstepB + kstep, voffB);
    PG8_WAIT_V(6); PG8_BAR;
    for (;;) {
        const bool has_next = S.next(ui + 1, nxt);
        const char* nA = has_next ? (const char*)g.A + (size_t)nxt.pm * tstepA + (size_t)nxt.ko * 2 : cA; const char* nB = has_next ? (const char*)g.Bt + (size_t)nxt.pn * tstepB + (size_t)nxt.ko * 2 : cB;
        for (int t = 0; t < nt; t += 2) {
            const bool last = (t == nt - 2);
            const char* a1 = cA + (size_t)(t + 1) * kstep;
            const char* a2 = last ? nA : cA + (size_t)(t + 2) * kstep; const char* b2 = last ? nB : cB + (size_t)(t + 2) * kstep;
            const char* a3 = a2 + kstep; const char* b3 = b2 + kstep;
            PG8_LDB(B0, 0, 0); PG8_LDB(B1, 0, 1); PG8_SCHED; PG8_LDA(At, 0, 0); PG8_STAGE(PG8_SA(1, 1), a1 + hstepA, voffA);
            PG8_WAIT_V(8); PG8_WAIT_L(0); PG8_BAR; PG8_MMA(0, 0, At, B0); PG8_MMA(0, 1, At, B1); PG8_BAR; PG8_SCHED;
            PG8_LDA(At, 0, 1); PG8_STAGE(PG8_SB(0, 0), b2, voffB); PG8_STAGE(PG8_SB(0, 1), b2 + hstepB, voffB); PG8_STAGE(PG8_SA(0, 0), a2, voffA);
            PG8_WAIT_V(8); PG8_WAIT_L(0); PG8_BAR; PG8_MMA(1, 0, At, B0); PG8_MMA(1, 1, At, B1); PG8_BAR; PG8_SCHED;
            PG8_LDB(B0, 1, 0); PG8_LDB(B1, 1, 1); PG8_SCHED; PG8_LDA(At, 1, 0); PG8_STAGE(PG8_SA(0, 1), a2 + hstepA, voffA);
            PG8_WAIT_V(8); PG8_WAIT_L(0); PG8_BAR; PG8_MMA(0, 0, At, B0); PG8_MMA(0, 1, At, B1); PG8_BAR; PG8_SCHED;
            PG8_LDA(At, 1, 1); PG8_STAGE(PG8_SB(1, 0), b3, voffB); PG8_STAGE(PG8_SB(1, 1), b3 + hstepB, voffB); PG8_STAGE(PG8_SA(1, 0), a3, voffA);
            PG8_WAIT_V(8); PG8_WAIT_L(0); PG8_BAR; PG8_MMA(1, 0, At, B0); PG8_MMA(1, 1, At, B1); PG8_BAR; PG8_SCHED;
        }
        if (wr == 0) PG8_BAR;
        E(acc, cur, wr, wc, fr, fq);
        if (!has_next) break;
#pragma unroll
        for (int a = 0; a < 2; ++a)
#pragma unroll
            for (int b = 0; b < 2; ++b)
#pragma unroll
                for (int m = 0; m < 4; ++m)
#pragma unroll
                    for (int n = 0; n < 2; ++n) acc[a][b][m][n] = (f32x4){0.f, 0.f, 0.f, 0.f};
        cur = nxt; cA = nA; cB = nB; ++ui;
        if (wr == 1) PG8_BAR;
    }
    PG8_WAIT_V(0);
    PG8_BAR;
#undef PG8_SA
#undef PG8_SB
#undef PG8_STAGE
#undef PG8_LDA
#undef PG8_LDB
#undef PG8_MMA
#undef PG8_WAIT_V
#undef PG8_WAIT_L
#undef PG8_BAR
#undef PG8_SCHED
}

template <int ACT> struct EpiBf16 {
    static constexpr bool PERM = true;
    bf16_t* d0; int ld0; int split;
    DI void operator()(const f32x4 (&acc)[2][2][4][2], const Unit& u, int wr, int wc, int fr_, int fq_) const {
        int fr = fr_, fq = fq_; asm volatile("" : "+v"(fr), "+v"(fq));
        bf16_t* base = d0; int ldc = ld0, t0 = 0;
        if (split) { const int sg = (u.pn >> 2) < 3 ? (u.pn >> 2) : 3; base = d0 + (size_t)(sg < 3 ? sg : 4) * ((size_t)MROWS * 1024); ldc = sg < 3 ? 1024 : P2W; t0 = sg * 4; }
        const int row0 = u.pm * BM + wr * 64 + fr, col0 = (u.pn - t0) * BM + wc * 32 + 8 * fq;
#pragma unroll
        for (int ai = 0; ai < 2; ++ai)
#pragma unroll
            for (int m = 0; m < 4; ++m) { bf16_t* rowp = base + (size_t)(row0 + ai * HALF + m * 16) * ldc + col0;
#pragma unroll
                for (int bj = 0; bj < 2; ++bj) { f32x4 v0 = acc[ai][bj][m][0], v1 = acc[ai][bj][m][1];
                    if (ACT == 1) {
#pragma unroll
                        for (int j = 0; j < 4; ++j) { const float a = fmaxf(v0[j], 0.f), b = fmaxf(v1[j], 0.f); v0[j] = a * a; v1[j] = b * b; } }
                    u32x4 w; w.x = cvt_pk_bf16(v0[0], v0[1]); w.y = cvt_pk_bf16(v0[2], v0[3]); w.z = cvt_pk_bf16(v1[0], v1[1]); w.w = cvt_pk_bf16(v1[2], v1[3]);
                    *(u32x4*)(rowp + bj * HALF) = w; } }
    }
};
struct EpiResid {
    static constexpr bool PERM = true;
    const void* src; void* dst; const float* gate; int sb, db;
    DI void operator()(const f32x4 (&acc)[2][2][4][2], const Unit& u, int wr, int wc, int fr_, int fq_) const {
        int fr = fr_, fq = fq_; asm volatile("" : "+v"(fr), "+v"(fq));
        const int b = u.pm / 33, tt = u.pm % 33;
        const size_t roff = ((size_t)b * SEQ + (size_t)(tt - 1) * 256) * DM;
        const float* gp = gate + (size_t)b * 12288;
        const int col0 = u.pn * BM + wc * 32 + 8 * fq;
        f32x4 gq[2][2];
#pragma unroll
        for (int bj = 0; bj < 2; ++bj) { gq[bj][0] = *(const f32x4*)(gp + col0 + bj * HALF); gq[bj][1] = *(const f32x4*)(gp + col0 + bj * HALF + 4); }
        if (sb) {
#pragma unroll
            for (int ai = 0; ai < 2; ++ai) {
                u32x4 pre[4][2];
#pragma unroll
                for (int m = 0; m < 4; ++m) { const size_t off = roff + (size_t)(ai * HALF + wr * 64 + m * 16 + fr) * DM + col0;
#pragma unroll
                    for (int bj = 0; bj < 2; ++bj) pre[m][bj] = *(const u32x4*)((const bf16_t*)src + off + bj * HALF); }
#pragma unroll
                for (int m = 0; m < 4; ++m) { const size_t off = roff + (size_t)(ai * HALF + wr * 64 + m * 16 + fr) * DM + col0;
#pragma unroll
                    for (int bj = 0; bj < 2; ++bj) { const int cc = bj * HALF; const u32x4 w = pre[m][bj];
                        const f32x4 s0 = (f32x4){bf2f(w.x & 0xffff), bf2f(w.x >> 16), bf2f(w.y & 0xffff), bf2f(w.y >> 16)}, s1 = (f32x4){bf2f(w.z & 0xffff), bf2f(w.z >> 16), bf2f(w.w & 0xffff), bf2f(w.w >> 16)};
                        const f32x4 o0 = s0 + gq[bj][0] * acc[ai][bj][m][0], o1 = s1 + gq[bj][1] * acc[ai][bj][m][1];
                        if (db) { u32x4 o; o.x = cvt_pk_bf16(o0[0], o0[1]); o.y = cvt_pk_bf16(o0[2], o0[3]); o.z = cvt_pk_bf16(o1[0], o1[1]); o.w = cvt_pk_bf16(o1[2], o1[3]); *(u32x4*)((bf16_t*)dst + off + cc) = o; }
                        else { *(f32x4*)((float*)dst + off + cc) = o0; *(f32x4*)((float*)dst + off + cc + 4) = o1; } } }
                asm volatile("" ::: "memory"); }
        } else {
#pragma unroll
            for (int ai = 0; ai < 2; ++ai)
#pragma unroll
                for (int m = 0; m < 4; ++m) { const size_t off = roff + (size_t)(ai * HALF + wr * 64 + m * 16 + fr) * DM + col0;
#pragma unroll
                    for (int bj = 0; bj < 2; ++bj) { const int cc = bj * HALF;
                        const f32x4 s0 = *(const f32x4*)((const float*)src + off + cc), s1 = *(const f32x4*)((const float*)src + off + cc + 4);
                        const f32x4 o0 = s0 + gq[bj][0] * acc[ai][bj][m][0], o1 = s1 + gq[bj][1] * acc[ai][bj][m][1];
                        if (db) { u32x4 o; o.x = cvt_pk_bf16(o0[0], o0[1]); o.y = cvt_pk_bf16(o0[2], o0[3]); o.z = cvt_pk_bf16(o1[0], o1[1]); o.w = cvt_pk_bf16(o1[2], o1[3]); *(u32x4*)((bf16_t*)dst + off + cc) = o; }
                        else { *(f32x4*)((float*)dst + off + cc) = o0; *(f32x4*)((float*)dst + off + cc + 4) = o1; } }
                    if (m & 1) asm volatile("" ::: "memory"); }
        }
    }
};
struct EpiPartial {
    static constexpr bool PERM = true;
    float* part; int ksub;
    DI void operator()(const f32x4 (&acc)[2][2][4][2], const Unit& u, int wr, int wc, int fr_, int fq_) const {
        int fr = fr_, fq = fq_; asm volatile("" : "+v"(fr), "+v"(fq));
        const int b = u.pm / 33, ks = u.ko / ksub;
        float* dp = part + ((size_t)ks * 512 + (size_t)b * 256) * DM;
        const int col0 = u.pn * BM + wc * 32 + 8 * fq;
#pragma unroll
        for (int ai = 0; ai < 2; ++ai)
#pragma unroll
            for (int m = 0; m < 4; ++m) { float* q = dp + (size_t)(ai * HALF + wr * 64 + m * 16 + fr) * DM + col0;
#pragma unroll
                for (int bj = 0; bj < 2; ++bj) { *(f32x4*)(q + bj * HALF) = acc[ai][bj][m][0]; *(f32x4*)(q + bj * HALF + 4) = acc[ai][bj][m][1]; } }
    }
};
struct EpiDft1 {
    static constexpr bool PERM = false;
    bf16_t* B2t;
    DI void operator()(const f32x4 (&acc)[2][2][4][2], const Unit& u, int wr, int wc, int fr_, int fq_) const {
        int fr = fr_, fq = fq_; asm volatile("" : "+v"(fr), "+v"(fq));
#pragma unroll
        for (int m = 0; m < 4; ++m) { const int c = wr * 64 + m * 16 + fr;
#pragma unroll
            for (int bj = 0; bj < 2; ++bj)
#pragma unroll
                for (int n = 0; n < 2; ++n) { const int nl = bj * HALF + wc * 32 + n * 16 + 4 * fq; const int colg = u.pn * 4 + (nl >> 6), b0 = nl & 63;
                    const f32x4 ar = acc[0][bj][m][n], ai = acc[1][bj][m][n]; float xr[4], xi[4];
#pragma unroll
                    for (int j = 0; j < 4; ++j) { const float ph = (float)((b0 + j) * c) * (6.283185307179586f / 8192.f); const float cs = __cosf(ph), sn = __sinf(ph);
                        xr[j] = ar[j] * cs + ai[j] * sn; xi[j] = ai[j] * cs - ar[j] * sn; }
                    bf16_t* q = B2t + ((size_t)c * 1024 + colg) * 128 + b0;
                    u32x2 w; w.x = cvt_pk_bf16(xr[0], xr[1]); w.y = cvt_pk_bf16(xr[2], xr[3]); *(u32x2*)q = w;
                    w.x = cvt_pk_bf16(xi[0], xi[1]); w.y = cvt_pk_bf16(xi[2], xi[3]); *(u32x2*)(q + 64) = w; } }
    }
};
struct EpiDft2 {
    static constexpr bool PERM = true;
    bf16_t* PQ;
    DI void operator()(const f32x4 (&acc)[2][2][4][2], const Unit& u, int wr, int wc, int fr_, int fq_) const {
        int fr = fr_, fq = fq_; asm volatile("" : "+v"(fr), "+v"(fq));
        const int c = u.pn >> 2;
#pragma unroll
        for (int m = 0; m < 4; ++m) { const int d = m * 16 + fr;
#pragma unroll
            for (int bj = 0; bj < 2; ++bj) { const int colg = (u.pn & 3) * BM + bj * HALF + wc * 32 + 8 * fq; const int batch = colg >> 9, ch = colg & 511;
                const f32x4 v0 = acc[0][bj][m][0], v1 = acc[0][bj][m][1];
                u32x4 w; w.x = cvt_pk_bf16(v0[0], v0[1]); w.y = cvt_pk_bf16(v0[2], v0[3]); w.z = cvt_pk_bf16(v1[0], v1[1]); w.w = cvt_pk_bf16(v1[2], v1[3]);
                *(u32x4*)(PQ + ((size_t)batch * TPB + CTXL + c + 128 * d) * 1024 + wr * 512 + ch) = w; } }
    }
};
struct EpiDftCtx {
    static constexpr bool PERM = false;
    bf16_t* PQ;
    DI void operator()(const f32x4 (&acc)[2][2][4][2], const Unit& u, int wr, int wc, int fr_, int fq_) const {
        int fr = fr_, fq = fq_; asm volatile("" : "+v"(fr), "+v"(fq));
        const int b = u.pn >> 1; const int colt = (u.pn & 1) * BM + wc * 32 + 4 * fq;
        bf16_t* base = PQ + (size_t)b * TPB * 1024 + (u.pm ? 512 : 0);
#pragma unroll
        for (int ai = 0; ai < 2; ++ai)
#pragma unroll
            for (int m = 0; m < 4; ++m) { const int k1 = ai * HALF + wr * 64 + m * 16 + fr;
#pragma unroll
                for (int bj = 0; bj < 2; ++bj)
#pragma unroll
                    for (int n = 0; n < 2; ++n) { const int c = colt + bj * HALF + n * 16; const f32x4 v = acc[ai][bj][m][n];
                        u32x2 w; w.x = cvt_pk_bf16(v[0], v[1]); w.y = cvt_pk_bf16(v[2], v[3]);
                        *(u32x2*)(base + (size_t)k1 * 1024 + c) = w; } }
    }
};
}

namespace att {
constexpr int QP = 272, VP = 144;
constexpr int Q_OFF = 0, K_OFF = 256 * QP  , K_BYTES = 64 * QP  , V_OFF = K_OFF + 2 * K_BYTES  , V_BYTES = 128 * VP  ;
static_assert(V_OFF + 3 * V_BYTES <= LDS_BYTES - 16, "attention LDS (3 V buffers)");
#define MFMA32(a, b, c) __builtin_amdgcn_mfma_f32_32x32x16_bf16((a), (b), (c), 0, 0, 0)
DI bf16x8 pack8(float a0, float a1, float a2, float a3, float a4, float a5, float a6, float a7) {
    u32x4 p;
    asm volatile("v_cvt_pk_bf16_f32 %0, %4, %5\n\tv_cvt_pk_bf16_f32 %1, %6, %7\n\tv_cvt_pk_bf16_f32 %2, %8, %9\n\tv_cvt_pk_bf16_f32 %3, %10, %11\n\ts_nop 1"
                 : "=&v"(p[0]), "=&v"(p[1]), "=&v"(p[2]), "=&v"(p[3])
                 : "v"(a0), "v"(a1), "v"(a2), "v"(a3), "v"(a4), "v"(a5), "v"(a6), "v"(a7));
    return __builtin_bit_cast(bf16x8, p);
}
template <bool SHIFT> DI void attn_unit(LAS unsigned char* lds, const bf16_t* Qb, const bf16_t* Kb, const bf16_t* Vt, bf16_t* concat,
                  int b, int h, int qt, float shift2, float lam, int lam_init_bits, const float* subln_g) {
    const int tid = TID(), wid = __builtin_amdgcn_readfirstlane(tid >> 6), lane = tid & 63, r = lane & 31, hh = lane >> 5;
    const size_t rowbase = (size_t)b * TPB;
    const int q0 = qt * 256;
    const int nkt = (qt == 0) ? 4 : NCH;
    const bf16_t* kg = Kb + rowbase * 1024 + h * 128;
    const bf16_t* vg = Vt + ((size_t)(b * 8 + h) * 128) * TPB;
    const int krow0 = tid >> 4, kc = tid & 15;
    const int vrow0 = tid >> 3, vc = tid & 7;
#pragma unroll
    for (int i = 0; i < 8; ++i) { const int id = i * 512 + tid, row = id >> 4, c = id & 15;
        const u32x4 v = *(const u32x4*)(Qb + (rowbase + q0 + row) * 1024 + h * 128 + c * 8);
        *(LAS u32x4*)(lds + Q_OFF + row * QP + c * 16) = v; }
    u32x4 sg0, sg1;
    sg0 = *(const u32x4*)(kg + (size_t)(krow0) * 1024 + kc * 8); sg1 = *(const u32x4*)(kg + (size_t)(krow0 + 32) * 1024 + kc * 8);
    *(LAS u32x4*)(lds + K_OFF + krow0 * QP + kc * 16) = sg0; *(LAS u32x4*)(lds + K_OFF + (krow0 + 32) * QP + kc * 16) = sg1;
    sg0 = *(const u32x4*)(vg + (size_t)(vrow0) * TPB + vc * 8); sg1 = *(const u32x4*)(vg + (size_t)(vrow0 + 64) * TPB + vc * 8);
    *(LAS u32x4*)(lds + V_OFF + vrow0 * VP + vc * 16) = sg0; *(LAS u32x4*)(lds + V_OFF + (vrow0 + 64) * VP + vc * 16) = sg1;
    if (nkt > 1) { sg0 = *(const u32x4*)(kg + (size_t)(64 + krow0) * 1024 + kc * 8); sg1 = *(const u32x4*)(kg + (size_t)(64 + krow0 + 32) * 1024 + kc * 8); }
    __syncthreads();
    f32x16 OT[2][4];
#pragma unroll
    for (int m = 0; m < 2; ++m)
#pragma unroll
        for (int t = 0; t < 4; ++t)
#pragma unroll
            for (int i = 0; i < 16; ++i) OT[m][t][i] = 0.f;
    float lsum[2] = {0.f, 0.f};
    const LAS unsigned char* qrow = lds + Q_OFF + (32 * wid + r) * QP + hh * 16;
#define SB0() __builtin_amdgcn_sched_barrier(0)
#define QKEXP(P_, half_) do { _Pragma("unroll") for (int m = 0; m < 2; ++m) { \
        f32x16 st; _Pragma("unroll") for (int i = 0; i < 16; ++i) st[i] = 0.f; \
        bf16x8 fq, fk; \
        fq = *(const LAS bf16x8*)(qrow + m * 128); fk = *(const LAS bf16x8*)(kb + (half_) * 32 * QP + m * 128); \
        _Pragma("unroll") for (int s = 0; s < 4; ++s) { \
            SB0(); st = MFMA32(fk, fq, st); SB0(); \
            if (s < 3) { fq = *(const LAS bf16x8*)(qrow + m * 128 + (s + 1) * 32); fk = *(const LAS bf16x8*)(kb + (half_) * 32 * QP + m * 128 + (s + 1) * 32); } } \
        float ls = 0.f; \
        _Pragma("unroll") for (int g_ = 0; g_ < 2; ++g_) { float e_[8]; _Pragma("unroll") for (int i_ = 0; i_ < 8; ++i_) { e_[i_] = __builtin_amdgcn_exp2f(SHIFT ? st[8 * g_ + i_] - shift2 : st[8 * g_ + i_]); ls += e_[i_]; } \
            P_[m][g_] = pack8(e_[0], e_[1], e_[2], e_[3], e_[4], e_[5], e_[6], e_[7]); SB0(); } \
        lsum[m] += ls; } } while (0)
#define PVH(P_, vptr_) do { bf16x8 fv; fv = *(const LAS bf16x8*)(vptr_); \
        _Pragma("unroll") for (int it = 0; it < 8; ++it) { const int mt = it & 3, sI = it >> 2; \
            SB0(); OT[0][mt] = MFMA32(fv, P_[0][sI], OT[0][mt]); OT[1][mt] = MFMA32(fv, P_[1][sI], OT[1][mt]); SB0(); \
            if (it < 7) { const int mt2 = (it + 1) & 3, s2 = (it + 1) >> 2; fv = *(const LAS bf16x8*)((vptr_) + mt2 * 32 * VP + s2 * 32); } } } while (0)
    const bool lag = wid >= 4;
    bf16x8 Pc[2][2];
#pragma unroll
    for (int m = 0; m < 2; ++m)
#pragma unroll
        for (int g = 0; g < 2; ++g) { u32x4 z = {0u, 0u, 0u, 0u}; Pc[m][g] = __builtin_bit_cast(bf16x8, z); }
    const LAS unsigned char* vold = lds + V_OFF + r * VP + hh * 16;
    int vcur = 0;
    for (int kt = 0; kt < nkt; ++kt) {
        const int cur = kt & 1, nx = cur ^ 1;
        const int vnx = vcur == 2 ? 0 : vcur + 1;
        const bool pf = (kt + 1 < nkt);
        const size_t ko = (size_t)(kt + 1) * 64;
        if (pf) { *(LAS u32x4*)(lds + K_OFF + nx * K_BYTES + krow0 * QP + kc * 16) = sg0; *(LAS u32x4*)(lds + K_OFF + nx * K_BYTES + (krow0 + 32) * QP + kc * 16) = sg1;
            sg0 = *(const u32x4*)(vg + (size_t)(vrow0) * TPB + ko + vc * 8); sg1 = *(const u32x4*)(vg + (size_t)(vrow0 + 64) * TPB + ko + vc * 8); }
        const LAS unsigned char* kb = lds + K_OFF + cur * K_BYTES + r * QP + hh * 16;
        const LAS unsigned char* vb = lds + V_OFF + vcur * V_BYTES + r * VP + hh * 16;
#pragma unroll
        for (int half = 0; half < 2; ++half) {
            if (lag) PVH(Pc, vold);
            QKEXP(Pc, half);
            if (half == 0 && pf) { *(LAS u32x4*)(lds + V_OFF + vnx * V_BYTES + vrow0 * VP + vc * 16) = sg0; *(LAS u32x4*)(lds + V_OFF + vnx * V_BYTES + (vrow0 + 64) * VP + vc * 16) = sg1;
                if (kt + 2 < nkt) { sg0 = *(const u32x4*)(kg + (ko + 64 + krow0) * 1024 + kc * 8); sg1 = *(const u32x4*)(kg + (ko + 64 + krow0 + 32) * 1024 + kc * 8); } }
            vold = vb + half * 64;
            SB0();
            if (!lag) PVH(Pc, vold);
        }
        __syncthreads();
        vcur = vnx;
    }
    if (lag) PVH(Pc, vold);
#undef QKEXP
#undef PVH
#undef SB0
    const float l0 = lsum[0] + __shfl_xor(lsum[0], 32), l1 = lsum[1] + __shfl_xor(lsum[1], 32);
    const float i0 = 1.f / l0, c1 = lam / l1;
    float ss = 0.f;
#pragma unroll
    for (int mt = 0; mt < 4; ++mt)
#pragma unroll
        for (int i = 0; i < 16; ++i) { const float o = OT[0][mt][i] * i0 - OT[1][mt][i] * c1; OT[0][mt][i] = o; ss += o * o; }
    ss += __shfl_xor(ss, 32);
    int lib = lam_init_bits; asm volatile("" : "+s"(lib));
    const float rs = rsqrtf(ss * (1.f / 128.f) + EPS) * (1.f - __builtin_bit_cast(float, lib));
    LAS unsigned char* stg = lds + Q_OFF + (32 * wid) * QP;
#pragma unroll
    for (int mt = 0; mt < 4; ++mt)
#pragma unroll
        for (int g = 0; g < 4; ++g) { const int dv0 = 32 * mt + 8 * g + 4 * hh; const f32x4 gv = *(const f32x4*)(subln_g + dv0);
            u32x2 w; w.x = pk2(OT[0][mt][4 * g] * rs * gv[0], OT[0][mt][4 * g + 1] * rs * gv[1]); w.y = pk2(OT[0][mt][4 * g + 2] * rs * gv[2], OT[0][mt][4 * g + 3] * rs * gv[3]);
            *(LAS u32x2*)(stg + r * QP + dv0 * 2) = w; }
    LDS_WAIT();
#pragma unroll
    for (int i = 0; i < 8; ++i) { const int id = i * 64 + lane, row = id >> 4, c = id & 15;
        const u32x4 v = *(const LAS u32x4*)(stg + row * QP + c * 16);
        *(u32x4*)(concat + (rowbase + q0 + 32 * wid + row) * DM + h * 128 + c * 8) = v; }
    __syncthreads();
}
}

struct Params { const float* in[20]; float* out; unsigned char* ws; int ph_lo, ph_hi, coop, pad; };
enum { I_X = 0, I_C, I_CTX, I_CCTX, I_WMOD, I_BMOD, I_N1G, I_N2G, I_WIN, I_QG, I_KG, I_LAM, I_SUBLN, I_WUP, I_BUP, I_GLAG, I_WF, I_WOUT, I_WFF1, I_WFF2 };

typedef const __attribute__((address_space(4))) Params* KParamsPtr;
DI KParamsPtr KP() { KParamsPtr q = (KParamsPtr)__builtin_amdgcn_kernarg_segment_ptr(); asm volatile("" : "+s"(q)); return q; }
#define PRM (*KP())

DI void tr_item(const float* W, int ldw, int k0, int srcc0, bf16_t* WT, int K, int dstr0, LAS float* scr, int lane) {
#pragma unroll
    for (int i = 0; i < 32; ++i) { const int kk = 2 * i + (lane >> 5); scr[kk * 33 + (lane & 31)] = srcc0 >= 0 ? W[(size_t)(k0 + kk) * ldw + srcc0 + (lane & 31)] : 0.f; }
    LDS_WAIT();
    const int c = lane & 7;
#pragma unroll
    for (int j = 0; j < 4; ++j) { const int n = (lane >> 3) + 8 * j; const LAS float* s = scr + (8 * c) * 33 + n;
        u32x4 o; o.x = pk2(s[0 * 33], s[1 * 33]); o.y = pk2(s[2 * 33], s[3 * 33]); o.z = pk2(s[4 * 33], s[5 * 33]); o.w = pk2(s[6 * 33], s[7 * 33]);
        *(u32x4*)(WT + (size_t)(dstr0 + n) * K + k0 + 8 * c) = o; }
    LDS_WAIT();
}
DI int win_src_col(int n0) {
    if (n0 < 3072 + 1536) return n0;
    if (n0 < 3072 + 2048) return 4640 + (n0 - 4608);
    if (n0 < 3072 + 2080) return 4608 + (n0 - 5120);
    return -1;
}

DI void phase_prep(LAS unsigned char* lds, int l) {
    const int tid = TID(), wid = tid >> 6, lane = tid & 63, G = GDIM(), bx = BID();
    unsigned char* ws = LP(PRM.ws);
    LAS float* tab = (LAS float*)lds;
    for (int m = tid; m < 8192; m += 512) tab[m] = __cosf((float)m * (6.283185307179586f / 8192.f));
    __syncthreads();
    {
        bf16_t* A1 = (bf16_t*)(ws + WS_A1); bf16_t* A2 = (bf16_t*)(ws + WS_A2);
        for (int idx = bx * 512 + tid; idx < 2 * 256 * 128; idx += G * 512) {
            const int which = idx >> 15, m = (idx >> 7) & 255, k = idx & 127; float v;
            if (which == 0) { const int c = m & 127; const float cs = tab[(unsigned)(k * c * 64) & 8191u], sn = tab[((unsigned)(k * c * 64) + 8192u - 2048u) & 8191u]; v = (m < 128 ? cs : -sn) * (1.f / 1024.f); A1[m * 128 + k] = (bf16_t)f2bf(v); }
            else { const int d = m & 63, bb = k & 63; const float cs = tab[(unsigned)(bb * d * 128) & 8191u], sn = tab[((unsigned)(bb * d * 128) + 8192u - 2048u) & 8191u];
                if (m < 64) v = k < 64 ? cs : sn; else if (m < 128) v = k < 64 ? sn : -cs; else v = 0.f;
                A2[m * 128 + k] = (bf16_t)f2bf(v); } }
        if (l == 0) {
            bf16_t* Tc = (bf16_t*)(ws + WS_TCTX);
            for (int id = bx * 512 + tid; id < 512 * 32; id += G * 512) {
                const int rr = id >> 5, n0 = (id & 31) * 8; const bool sp = rr >= 256; const unsigned k1 = sp ? rr - 256 : rr; const unsigned sh = sp ? 8192u - 2048u : 0u;
                float v[8];
#pragma unroll
                for (int j = 0; j < 8; ++j) v[j] = tab[(k1 * (unsigned)(n0 + j) * 32u + sh) & 8191u] * 0.005524271728019903f;
                u32x4 o; o.x = pk2(v[0], v[1]); o.y = pk2(v[2], v[3]); o.z = pk2(v[4], v[5]); o.w = pk2(v[6], v[7]);
                *(u32x4*)(Tc + (size_t)id * 8) = o; } }
        const float* wf = PRM.in[I_WF] + (size_t)l * 512 * 512; bf16_t* Wcs = (bf16_t*)(ws + WS_WCS);
        for (int idx = bx * 512 + tid; idx < 512 * 1024; idx += G * 512) {
            const int j = idx & 511, kk = idx >> 9; const bool sp = kk >= 512; const int k2i = kk & 511, g = k2i >> 7, n2 = k2i & 127; const unsigned sh = sp ? 8192u - 2048u : 0u;
            float acc = 0.f;
            for (int k2 = 0; k2 < 128; ++k2) acc += tab[((unsigned)((k2 * n2) & 127) * 64u + sh) & 8191u] * wf[(size_t)(g * 128 + k2) * 512 + j];
            Wcs[(size_t)j * 1024 + kk] = (bf16_t)f2bf(sp ? -acc : acc); }
    }
    {
        LAS float* scr = (LAS float*)(lds + 32768 + wid * 8448);
        const int gw = bx * 8 + wid, NGW = G * 8;
        constexpr int I_IN = 32 * (NIN / 32), I_OUT = 32 * 64, I_F1 = 32 * 256, I_F2 = 128 * 64;
        const float* win = PRM.in[I_WIN] + (size_t)l * DM * DIN; const float* wout = PRM.in[I_WOUT] + (size_t)l * DM * DM;
        const float* wf1 = PRM.in[I_WFF1] + (size_t)l * DM * DFF; const float* wf2 = PRM.in[I_WFF2] + (size_t)l * DFF * DM;
        for (int it = gw; it < I_IN + I_OUT + I_F1 + I_F2; it += NGW) {
            int r = it;
            if (r < I_IN) { const int nb = r % (NIN / 32), kb = r / (NIN / 32); tr_item(win, DIN, kb * 64, win_src_col(nb * 32), (bf16_t*)(ws + WS_WIN), DM, nb * 32, scr, lane); continue; } r -= I_IN;
            if (r < I_OUT) { const int nb = r % 64, kb = r / 64; tr_item(wout, DM, kb * 64, nb * 32, (bf16_t*)(ws + WS_WOUT), DM, nb * 32, scr, lane); continue; } r -= I_OUT;
            if (r < I_F1) { const int nb = r % 256, kb = r / 256; tr_item(wf1, DFF, kb * 64, nb * 32, (bf16_t*)(ws + WS_WFF1), DM, nb * 32, scr, lane); continue; } r -= I_F1;
            { const int nb = r % 64, kb = r / 64; tr_item(wf2, DM, kb * 64, nb * 32, (bf16_t*)(ws + WS_WFF2), DFF, nb * 32, scr, lane); }
        }
    }
    __syncthreads();
    if (l == 0) {
        LAS float* sv = (LAS float*)lds;
        LAS float* red = (LAS float*)(lds + 24576);
        for (int i = tid; i < 3 * 2048; i += 512) { const int s = i >> 11, k = i & 2047; const float c = s < 2 ? PRM.in[I_C][s * 2048 + k] : PRM.in[I_CCTX][k]; sv[i] = c / (1.f + __expf(-c)); }
        __syncthreads();
        float* mod = (float*)(ws + WS_MOD);
        const int cl = tid & 15, ks = tid >> 4;
        for (int item = bx; item < 2 * 192; item += G) {
            const int l2 = item / 192, j0 = (item % 192) * 64;
            const float* wm = PRM.in[I_WMOD] + ((size_t)l2 * 2048 + ks * 64) * 12288 + j0 + cl * 4;
            f32x4 a0 = {0.f, 0.f, 0.f, 0.f}, a1 = a0, a2 = a0;
#pragma unroll 8
            for (int kk = 0; kk < 64; ++kk) { const f32x4 w = *(const f32x4*)(wm + (size_t)kk * 12288); const int k = ks * 64 + kk;
                a0 += w * sv[k]; a1 += w * sv[2048 + k]; a2 += w * sv[4096 + k]; }
#pragma unroll
            for (int i = 0; i < 4; ++i) { red[(ks * 3 + 0) * 64 + cl * 4 + i] = a0[i]; red[(ks * 3 + 1) * 64 + cl * 4 + i] = a1[i]; red[(ks * 3 + 2) * 64 + cl * 4 + i] = a2[i]; }
            __syncthreads();
            if (tid < 192) { const int s = tid >> 6, ci = tid & 63; float t = PRM.in[I_BMOD][(size_t)l2 * 12288 + j0 + ci];
                for (int k2 = 0; k2 < 32; ++k2) t += red[(k2 * 3 + s) * 64 + ci];
                mod[((size_t)l2 * 3 + s) * 12288 + j0 + ci] = t; }
            __syncthreads();
        }
    }
}

DI const float* hrow_in(int l, int b, int t) {
    if (l == 0) return t < CTXL ? PRM.in[I_CTX] + ((size_t)b * CTXL + t) * DM : PRM.in[I_X] + ((size_t)b * SEQ + (t - CTXL)) * DM;
    return t < CTXL ? (const float*)(LP(PRM.ws) + WS_XC) + ((size_t)b * CTXL + t) * DM : PRM.out + ((size_t)b * SEQ + (t - CTXL)) * DM;
}
DI void phase_norm(int l, int stage, bool skipctx, int fold, int gate_l, int gate_chunk, const void* latsrc, int lat_bf16) {
    const int tid = TID(), wid = tid >> 6, lane = tid & 63;
    const float* mod = (const float*)(LP(PRM.ws) + WS_MOD); bf16_t* A = (bf16_t*)(LP(PRM.ws) + WS_A);
    const float* gvec = PRM.in[stage == 0 ? I_N1G : I_N2G] + (size_t)l * DM;
    f32x4 ggv[8], shv[8]; int cur_s = -1;
    for (int row = BID() * 8 + wid; row < MROWS; row += GDIM() * 8) {
        const int b = row / TPB, t = row % TPB; const bool isctx = t < CTXL;
        if (skipctx && isctx) continue;
        const int ssel = isctx ? 2 : b;
        if (ssel != cur_s) { cur_s = ssel;
            const float* sh = mod + ((size_t)l * 3 + ssel) * 12288 + (size_t)(stage * 3) * DM; const float* sc = sh + DM;
#pragma unroll
            for (int j = 0; j < 8; ++j) { const int c = 4 * (64 * j + lane); ggv[j] = *(const f32x4*)(gvec + c) * (*(const f32x4*)(sc + c) + 1.f); shv[j] = *(const f32x4*)(sh + c); } }
        const float* src = hrow_in(stage == 0 ? l : 1, b, t);
        if (isctx && fold == 1) src = PRM.in[I_CTX] + ((size_t)b * CTXL + t) * DM;
        f32x4 v[8]; float ss = 0.f;
        if (!isctx && lat_bf16) { const bf16_t* sb_ = (const bf16_t*)latsrc + ((size_t)b * SEQ + (t - CTXL)) * DM;
#pragma unroll
            for (int j = 0; j < 8; ++j) { const u32x2 w = *((const u32x2*)sb_ + 64 * j + lane); v[j] = (f32x4){bf2f(w.x & 0xffff), bf2f(w.x >> 16), bf2f(w.y & 0xffff), bf2f(w.y >> 16)}; } }
        else { if (!isctx) src = (const float*)latsrc + ((size_t)b * SEQ + (t - CTXL)) * DM;
#pragma unroll
            for (int j = 0; j < 8; ++j) v[j] = *((const f32x4*)src + 64 * j + lane); }
        if (isctx && fold) {
            const float* part = (const float*)(LP(PRM.ws) + WS_PART) + ((size_t)b * CTXL + t) * DM; const float* gt = mod + ((size_t)gate_l * 3 + 2) * 12288 + (size_t)gate_chunk * DM;
            float* xc = (float*)(LP(PRM.ws) + WS_XC) + ((size_t)b * CTXL + t) * DM;
#pragma unroll
            for (int j = 0; j < 8; ++j) { f32x4 a = *((const f32x4*)part + 64 * j + lane);
#pragma unroll
                for (int k = 1; k < NSPLIT; ++k) a += *((const f32x4*)(part + (size_t)k * 512 * DM) + 64 * j + lane);
                v[j] += a * *((const f32x4*)gt + 64 * j + lane); *((f32x4*)xc + 64 * j + lane) = v[j]; }
        }
#pragma unroll
        for (int j = 0; j < 8; ++j) ss += (v[j][0] * v[j][0] + v[j][1] * v[j][1]) + (v[j][2] * v[j][2] + v[j][3] * v[j][3]);
        const float rs = rsqrtf(wave_sum(ss) * (1.f / DM) + EPS);
#pragma unroll
        for (int j = 0; j < 8; ++j) { const int c = 4 * (64 * j + lane);
            const f32x4 y = v[j] * rs * ggv[j] + shv[j];
            u32x2 w; w.x = pk2(y[0], y[1]); w.y = pk2(y[2], y[3]); *(u32x2*)(A + (size_t)row * DM + c) = w; }
    }
}

DI void tr_unit(LAS unsigned char* lds, const bf16_t* src, int ld, bf16_t* dst, size_t dpitch, bool perm) {
    const int tid = TID();
#pragma unroll
    for (int i = 0; i < 2; ++i) { const int id = i * 512 + tid, row = id >> 4, c = id & 15;
        *(LAS u32x4*)(lds + row * 272 + c * 16) = *(const u32x4*)(src + (size_t)row * ld + c * 8); }
    __syncthreads();
#pragma unroll
    for (int i = 0; i < 2; ++i) { const int id = i * 512 + tid, j = id >> 3, c = id & 7; unsigned e[8];
#pragma unroll
        for (int q = 0; q < 8; ++q) { const int key = perm ? (16 * (c >> 1) + 8 * (q >> 2) + 4 * (c & 1) + (q & 3)) : (8 * c + q); e[q] = *(const LAS unsigned short*)(lds + key * 272 + j * 2); }
        u32x4 o; o.x = e[0] | (e[1] << 16); o.y = e[2] | (e[3] << 16); o.z = e[4] | (e[5] << 16); o.w = e[6] | (e[7] << 16);
        *(u32x4*)(dst + (size_t)j * dpitch + c * 8) = o; }
    __syncthreads();
}

DI void gla_load(LAS unsigned char* lds, int l, int b, int h, int c, int off_q  , int off_k, int off_v, int off_pa, int off_wup, int off_bup) {
    const int tid = TID();
    const bf16_t* P2 = (const bf16_t*)(LP(PRM.ws) + WS_P2) + ((size_t)b * TPB + (size_t)c * 64) * P2W;
    { const int row = tid >> 3, c8 = tid & 7;
      const u32x4 kv = *(const u32x4*)(P2 + (size_t)row * P2W + 256 + h * 64 + c8 * 8); LAS float* kd = (LAS float*)(lds + off_k) + row * 64 + c8 * 8;
      kd[0] = bf2f(kv.x & 0xffff); kd[1] = bf2f(kv.x >> 16); kd[2] = bf2f(kv.y & 0xffff); kd[3] = bf2f(kv.y >> 16); kd[4] = bf2f(kv.z & 0xffff); kd[5] = bf2f(kv.z >> 16); kd[6] = bf2f(kv.w & 0xffff); kd[7] = bf2f(kv.w >> 16);
      if (off_q >= 0) { const u32x4 qv = *(const u32x4*)(P2 + (size_t)row * P2W + h * 64 + c8 * 8); LAS float* qd = (LAS float*)(lds + off_q) + row * 64 + c8 * 8;
        qd[0] = bf2f(qv.x & 0xffff); qd[1] = bf2f(qv.x >> 16); qd[2] = bf2f(qv.y & 0xffff); qd[3] = bf2f(qv.y >> 16); qd[4] = bf2f(qv.z & 0xffff); qd[5] = bf2f(qv.z >> 16); qd[6] = bf2f(qv.w & 0xffff); qd[7] = bf2f(qv.w >> 16); } }
#pragma unroll
    for (int i = 0; i < 2; ++i) { const int id = i * 512 + tid, row = id >> 4, c8 = id & 15;
        const u32x4 vv = *(const u32x4*)(P2 + (size_t)row * P2W + 512 + h * 128 + c8 * 8); LAS float* vd = (LAS float*)(lds + off_v) + row * 128 + c8 * 8;
        vd[0] = bf2f(vv.x & 0xffff); vd[1] = bf2f(vv.x >> 16); vd[2] = bf2f(vv.y & 0xffff); vd[3] = bf2f(vv.y >> 16); vd[4] = bf2f(vv.z & 0xffff); vd[5] = bf2f(vv.z >> 16); vd[6] = bf2f(vv.w & 0xffff); vd[7] = bf2f(vv.w >> 16); }
    if (tid < 256) { const int row = tid >> 2, c8 = tid & 3;
        const u32x4 pv = *(const u32x4*)(P2 + (size_t)row * P2W + 2048 + c8 * 8); LAS float* pd = (LAS float*)(lds + off_pa) + row * 32 + c8 * 8;
        pd[0] = bf2f(pv.x & 0xffff); pd[1] = bf2f(pv.x >> 16); pd[2] = bf2f(pv.y & 0xffff); pd[3] = bf2f(pv.y >> 16); pd[4] = bf2f(pv.z & 0xffff); pd[5] = bf2f(pv.z >> 16); pd[6] = bf2f(pv.w & 0xffff); pd[7] = bf2f(pv.w >> 16); }
#pragma unroll
    for (int i = 0; i < 4; ++i) { const int idx = tid * 4 + i, d = idx >> 10, rr = (idx >> 6) & 15, dk = idx & 63;
        ((LAS float*)(lds + off_wup))[idx] = PRM.in[I_WUP][((size_t)(l * 2 + d) * 16 + rr) * 256 + h * 64 + dk]; }
    if (tid < 128) { const int d = tid >> 6, dk = tid & 63; ((LAS float*)(lds + off_bup))[tid] = PRM.in[I_BUP][(size_t)(l * 2 + d) * 256 + h * 64 + dk]; }
}
DI float gla_cumsum(const LAS float* paf, const LAS float* wup, const LAS float* bup, int d, int dk, LAS float* out) {
    float w[16];
#pragma unroll
    for (int rr = 0; rr < 16; ++rr) w[rr] = wup[(d * 16 + rr) * 64 + dk];
    const float bb = bup[d * 64 + dk];
    float run = 0.f;
    for (int s = 0; s < 64; ++s) { const int t = d ? 63 - s : s; float z = bb;
#pragma unroll
        for (int rr = 0; rr < 16; ++rr) z += paf[t * 32 + d * 16 + rr] * w[rr];
        run += logsig(z) * (1.f / 16.f); out[t * 64 + dk] = run; }
    return run;
}
DI void gla_g1_unit(LAS unsigned char* lds, int l, int b, int h, int c) {
    constexpr int OK = 0, OV = 16384, OPA = 49152, OWUP = 57344, OBUP = 65536, OE = 66560;
    const int tid = TID();
    gla_load(lds, l, b, h, c, -1, OK, OV, OPA, OWUP, OBUP);
    __syncthreads();
    const LAS float* kf = (const LAS float*)(lds + OK); const LAS float* vf = (const LAS float*)(lds + OV);
    LAS float* E = (LAS float*)(lds + OE);
    bf16_t* KV = (bf16_t*)(LP(PRM.ws) + WS_KV); float* DEC = (float*)(LP(PRM.ws) + WS_DEC);
    {
        const LAS float* paf = (const LAS float*)(lds + OPA); const LAS float* wup = (const LAS float*)(lds + OWUP); const LAS float* bup = (const LAS float*)(lds + OBUP);
        LAS float* bl_s = (LAS float*)(lds + OE + 32768);
        const int dk = tid & 63;
#pragma unroll
        for (int d = 0; d < 2; ++d) { float w[16];
#pragma unroll
            for (int rr = 0; rr < 16; ++rr) w[rr] = wup[(d * 16 + rr) * 64 + dk];
            const float bb = bup[d * 64 + dk];
            for (int t = tid >> 6; t < 64; t += 8) { float z = bb;
#pragma unroll
                for (int rr = 0; rr < 16; ++rr) z += paf[t * 32 + d * 16 + rr] * w[rr];
                E[d * 4096 + t * 64 + dk] = logsig(z) * (1.f / 16.f); } }
        __syncthreads();
        if (tid < 128) { const int d = tid >> 6; float run = 0.f;
            for (int s2 = 0; s2 < 64; ++s2) { const int t = d ? 63 - s2 : s2; run += E[d * 4096 + t * 64 + dk]; E[d * 4096 + t * 64 + dk] = run; }
            bl_s[d * 64 + dk] = run;
            DEC[((size_t)((b * 2 + d) * 4 + h) * NCH + c) * 64 + dk] = __expf(run); }
        __syncthreads();
#pragma unroll
        for (int i = 0; i < 16; ++i) { const int idx = i * 512 + tid, d = idx >> 12, td = idx & 4095; E[idx] = __expf(bl_s[d * 64 + (td & 63)] - E[idx]) * kf[td]; }
    }
    __syncthreads();
    { const int d = tid >> 8, tt = tid & 255, dvq = tt & 31, dkq = tt >> 5; const LAS float* Ed = E + d * 4096;
      f32x4 acc[8];
#pragma unroll
      for (int i = 0; i < 8; ++i) acc[i] = (f32x4){0.f, 0.f, 0.f, 0.f};
      for (int t = 0; t < 64; ++t) { const f32x4 vv = *(const LAS f32x4*)(vf + t * 128 + 4 * dvq);
#pragma unroll
          for (int i = 0; i < 8; ++i) acc[i] += vv * Ed[t * 64 + dkq * 8 + i]; }
      bf16_t* dst = KV + ((size_t)((b * 2 + d) * 4 + h) * NCH + c) * 8192;
#pragma unroll
      for (int i = 0; i < 8; ++i) { u32x2 w; w.x = pk2(acc[i][0], acc[i][1]); w.y = pk2(acc[i][2], acc[i][3]); *(u32x2*)(dst + (dkq * 8 + i) * 128 + 4 * dvq) = w; } }
    __syncthreads();
}
DI void gla_scan() {
    const int tid = TID(); unsigned* KV = (unsigned*)(LP(PRM.ws) + WS_KV); const float* DEC = (const float*)(LP(PRM.ws) + WS_DEC);
    for (int item = BID(); item < 128; item += GDIM()) {
        const int seq = item >> 3, slab = item & 7, d = (seq >> 2) & 1, e2 = slab * 512 + tid  , dk = e2 >> 6;
        float S0 = 0.f, S1 = 0.f;
        for (int s0 = 0; s0 < NCH; s0 += 33) { unsigned kvv[33]; float dc[33];
#pragma unroll
            for (int j = 0; j < 33; ++j) { const int st = s0 + j, c = d ? (st < 4 ? 3 - st : 135 - st) : st; kvv[j] = KV[((size_t)seq * NCH + c) * 4096 + e2]; dc[j] = DEC[((size_t)seq * NCH + c) * 64 + dk]; }
#pragma unroll
            for (int j = 0; j < 33; ++j) { const int st = s0 + j, c = d ? (st < 4 ? 3 - st : 135 - st) : st; KV[((size_t)seq * NCH + c) * 4096 + e2] = pk2(S0, S1);
                S0 = dc[j] * S0 + bf2f(kvv[j] & 0xffff); S1 = dc[j] * S1 + bf2f(kvv[j] >> 16); } }
    }
}
DI void gla_g3_unit(LAS unsigned char* lds, int l, int b, int h, int c) {
    constexpr int OQ = 0, OK = 16384, OPA = 32768, OWUP = 40960, OBUP = 49152, OG = 50176, OVT = 82944, OQE = 101376, OKE = 110592, OST = 119808, OOT = 0, PB = 144;
    const int tid = TID(), wid = __builtin_amdgcn_readfirstlane(tid >> 6), lane = tid & 63, r = lane & 31, hh = lane >> 5;
    const bf16_t* P2 = (const bf16_t*)(LP(PRM.ws) + WS_P2) + ((size_t)b * TPB + (size_t)c * 64) * P2W;
    {
        const int row = tid >> 3, c8 = tid & 7;
        const u32x4 kv = *(const u32x4*)(P2 + (size_t)row * P2W + 256 + h * 64 + c8 * 8); LAS float* kd = (LAS float*)(lds + OK) + row * 64 + c8 * 8;
        kd[0] = bf2f(kv.x & 0xffff); kd[1] = bf2f(kv.x >> 16); kd[2] = bf2f(kv.y & 0xffff); kd[3] = bf2f(kv.y >> 16); kd[4] = bf2f(kv.z & 0xffff); kd[5] = bf2f(kv.z >> 16); kd[6] = bf2f(kv.w & 0xffff); kd[7] = bf2f(kv.w >> 16);
        const u32x4 qv = *(const u32x4*)(P2 + (size_t)row * P2W + h * 64 + c8 * 8); LAS float* qd = (LAS float*)(lds + OQ) + row * 64 + c8 * 8;
        qd[0] = bf2f(qv.x & 0xffff); qd[1] = bf2f(qv.x >> 16); qd[2] = bf2f(qv.y & 0xffff); qd[3] = bf2f(qv.y >> 16); qd[4] = bf2f(qv.z & 0xffff); qd[5] = bf2f(qv.z >> 16); qd[6] = bf2f(qv.w & 0xffff); qd[7] = bf2f(qv.w >> 16);
#pragma unroll
        for (int i = 0; i < 2; ++i) { const int id = i * 512 + tid, m = id >> 4, cc = id & 15;
            const u32x4 vv = *(const u32x4*)(P2 + (size_t)m * P2W + 512 + h * 128 + cc * 8);
            const int m16 = m & 15, pos = (m & ~15) + 8 * ((m16 >> 2) & 1) + ((m16 >> 3) << 2) + (m16 & 3);
            LAS unsigned short* vt = (LAS unsigned short*)(lds + OVT + (cc * 8) * PB + pos * 2);
            vt[0 * (PB / 2)] = vv.x & 0xffff; vt[1 * (PB / 2)] = vv.x >> 16; vt[2 * (PB / 2)] = vv.y & 0xffff; vt[3 * (PB / 2)] = vv.y >> 16;
            vt[4 * (PB / 2)] = vv.z & 0xffff; vt[5 * (PB / 2)] = vv.z >> 16; vt[6 * (PB / 2)] = vv.w & 0xffff; vt[7 * (PB / 2)] = vv.w >> 16; }
        if (tid < 256) { const int prow = tid >> 2, p8 = tid & 3;
            const u32x4 pv = *(const u32x4*)(P2 + (size_t)prow * P2W + 2048 + p8 * 8); LAS float* pd = (LAS float*)(lds + OPA) + prow * 32 + p8 * 8;
            pd[0] = bf2f(pv.x & 0xffff); pd[1] = bf2f(pv.x >> 16); pd[2] = bf2f(pv.y & 0xffff); pd[3] = bf2f(pv.y >> 16); pd[4] = bf2f(pv.z & 0xffff); pd[5] = bf2f(pv.z >> 16); pd[6] = bf2f(pv.w & 0xffff); pd[7] = bf2f(pv.w >> 16); }
#pragma unroll
        for (int i = 0; i < 4; ++i) { const int idx = tid * 4 + i, d = idx >> 10, rr = (idx >> 6) & 15, dk = idx & 63;
            ((LAS float*)(lds + OWUP))[idx] = PRM.in[I_WUP][((size_t)(l * 2 + d) * 16 + rr) * 256 + h * 64 + dk]; }
        if (tid < 128) { const int d = tid >> 6, dk = tid & 63; ((LAS float*)(lds + OBUP))[tid] = PRM.in[I_BUP][(size_t)(l * 2 + d) * 256 + h * 64 + dk]; }
    }
    const bf16_t* KVp = (const bf16_t*)(LP(PRM.ws) + WS_KV);
    u32x4 sS[2][2]; u32x2 rG[4];
#pragma unroll
    for (int d = 0; d < 2; ++d) { const bf16_t* Sg = KVp + ((size_t)((b * 2 + d) * 4 + h) * NCH + c) * 8192;
#pragma unroll
        for (int i = 0; i < 2; ++i) { const int id = i * 512 + tid; sS[d][i] = *(const u32x4*)(Sg + (id >> 4) * 128 + (id & 15) * 8); } }
#pragma unroll
    for (int i = 0; i < 4; ++i) rG[i] = *(const u32x2*)(P2 + (size_t)(4 * (tid >> 5) + i) * P2W + 1024 + h * 128 + 4 * (tid & 31));
    __syncthreads();
    const LAS float* qf = (const LAS float*)(lds + OQ); const LAS float* kf = (const LAS float*)(lds + OK);
    const LAS float* paf = (const LAS float*)(lds + OPA); const LAS float* wup = (const LAS float*)(lds + OWUP); const LAS float* bup = (const LAS float*)(lds + OBUP);
    LAS float* gl = (LAS float*)(lds + OG);
    {
        const int dk = tid & 63;
#pragma unroll
        for (int d = 0; d < 2; ++d) { float w[16];
#pragma unroll
            for (int rr = 0; rr < 16; ++rr) w[rr] = wup[(d * 16 + rr) * 64 + dk];
            const float bb = bup[d * 64 + dk];
            for (int t = tid >> 6; t < 64; t += 8) { float z = bb;
#pragma unroll
                for (int rr = 0; rr < 16; ++rr) z += paf[t * 32 + d * 16 + rr] * w[rr];
                gl[d * 4096 + t * 64 + dk] = logsig(z) * (1.f / 16.f); } }
    }
    __syncthreads();
    if (tid < 128) { const int d = tid >> 6, dk = tid & 63; float run = 0.f;
        for (int s = 0; s < 64; ++s) { const int t = d ? 63 - s : s; run += gl[d * 4096 + t * 64 + dk]; gl[d * 4096 + t * 64 + dk] = run; } }
    __syncthreads();
    const int mt = wid & 3, ntl = wid >> 2;
    f32x16 acc;
#pragma unroll
    for (int i = 0; i < 16; ++i) acc[i] = 0.f;
    const bf16_t* KV = (const bf16_t*)(LP(PRM.ws) + WS_KV);
    for (int d = 0; d < 2; ++d) {
        {
#pragma unroll
            for (int i = 0; i < 4; ++i) { const int idx2 = (i * 512 + tid) * 2, t = idx2 >> 6, dk = idx2 & 63;
                const float b0 = gl[d * 4096 + idx2], b1 = gl[d * 4096 + idx2 + 1];
                *(LAS unsigned*)(lds + OQE + t * PB + dk * 2) = pk2(qf[idx2] * __expf(b0) * 0.125f, qf[idx2 + 1] * __expf(b1) * 0.125f);
                *(LAS unsigned*)(lds + OKE + t * PB + dk * 2) = pk2(kf[idx2] * __expf(-b0), kf[idx2 + 1] * __expf(-b1)); }
#pragma unroll
            for (int i = 0; i < 2; ++i) { const int id = i * 512 + tid, dk = id >> 4, dv8 = (id & 15) * 8; const u32x4 sv = d ? sS[1][i] : sS[0][i];
                LAS unsigned short* st = (LAS unsigned short*)(lds + OST + dv8 * PB + dk * 2);
                st[0] = sv.x & 0xffff; st[PB / 2] = sv.x >> 16; st[2 * (PB / 2)] = sv.y & 0xffff; st[3 * (PB / 2)] = sv.y >> 16;
                st[4 * (PB / 2)] = sv.z & 0xffff; st[5 * (PB / 2)] = sv.z >> 16; st[6 * (PB / 2)] = sv.w & 0xffff; st[7 * (PB / 2)] = sv.w >> 16; }
        }
        __syncthreads();
        {
            bf16x8 qfr[4];
#pragma unroll
            for (int s = 0; s < 4; ++s) qfr[s] = *(const LAS bf16x8*)(lds + OQE + (32 * ntl + r) * PB + s * 32 + hh * 16);
#pragma unroll
            for (int s = 0; s < 4; ++s) { const bf16x8 sf = *(const LAS bf16x8*)(lds + OST + (32 * mt + r) * PB + s * 32 + hh * 16); acc = MFMA32(sf, qfr[s], acc); }
#pragma unroll
            for (int j = 0; j < 2; ++j) {
                f32x16 at;
#pragma unroll
                for (int i = 0; i < 16; ++i) at[i] = 0.f;
#pragma unroll
                for (int s = 0; s < 4; ++s) { const bf16x8 kfr = *(const LAS bf16x8*)(lds + OKE + (32 * j + r) * PB + s * 32 + hh * 16); at = MFMA32(kfr, qfr[s], at); }
                const int tcol = 32 * ntl + r;
#pragma unroll
                for (int i = 0; i < 16; ++i) { const int m = 32 * j + (i & 3) + 8 * (i >> 2) + 4 * hh; const bool keep = d ? (m >= tcol) : (m <= tcol); at[i] = keep ? at[i] : 0.f; }
#pragma unroll
                for (int s = 0; s < 2; ++s) {
                    const bf16x8 pf = att::pack8(at[8 * s], at[8 * s + 1], at[8 * s + 2], at[8 * s + 3], at[8 * s + 4], at[8 * s + 5], at[8 * s + 6], at[8 * s + 7]);
                    const bf16x8 vfr = *(const LAS bf16x8*)(lds + OVT + (32 * mt + r) * PB + (2 * j + s) * 32 + hh * 16);
                    acc = MFMA32(vfr, pf, acc); }
            }
        }
        __syncthreads();
    }
    {
        LAS float* oT = (LAS float*)(lds + OOT);
        const int t = 32 * ntl + r;
#pragma unroll
        for (int i = 0; i < 16; ++i) { const int dv = 32 * mt + (i & 3) + 8 * (i >> 2) + 4 * hh; oT[t * 132 + dv] = acc[i]; }
    }
    __syncthreads();
    const int tq = tid >> 5, dvq = tid & 31;
    const f32x4 gg = *(const f32x4*)(PRM.in[I_GLAG] + (size_t)l * 128 + 4 * dvq);
    bf16_t* concat = (bf16_t*)(LP(PRM.ws) + WS_A);
#pragma unroll
    for (int i = 0; i < 4; ++i) { const f32x4 o = *(const LAS f32x4*)(lds + OOT + ((4 * tq + i) * 132 + 4 * dvq) * 4);
        float ss = (o[0] * o[0] + o[1] * o[1]) + (o[2] * o[2] + o[3] * o[3]);
#pragma unroll
        for (int s = 1; s < 32; s <<= 1) ss += __shfl_xor(ss, s);
        const float rs = rsqrtf(ss * (1.f / 128.f) + EPS);
        const size_t row = (size_t)c * 64 + 4 * tq + i;
        const u32x2 rv = rG[i];
        float r4[4] = {bf2f(rv.x & 0xffff), bf2f(rv.x >> 16), bf2f(rv.y & 0xffff), bf2f(rv.y >> 16)}; float y[4];
#pragma unroll
        for (int j = 0; j < 4; ++j) y[j] = o[j] * rs * gg[j] * (r4[j] / (1.f + __expf(-r4[j])));
        u32x2 w; w.x = pk2(y[0], y[1]); w.y = pk2(y[2], y[3]); *(u32x2*)(concat + ((size_t)b * TPB + row) * DM + 1024 + h * 128 + 4 * dvq) = w; }
    __syncthreads();
}

DI void phase_post(LAS unsigned char* lds, int l, bool do_qk) {
    const int tid = TID(), wid = tid >> 6, lane = tid & 63, G = GDIM(), bx = BID();
    unsigned char* ws = LP(PRM.ws);
    if (do_qk) {
        const int lp = lane & 31, d0 = 2 * lp, dd = d0 & 31, i0 = dd & 15; const bool axis = d0 >= 32; const float sgn = dd < 16 ? -1.f : 1.f;
        const float inv0 = exp2f(-(float)i0 * (13.287712379549449f / 16.f)), inv1 = exp2f(-(float)(i0 + 1) * (13.287712379549449f / 16.f));
        for (int row = bx * 8 + wid; row < MROWS; row += G * 8) {
            const int t = row % TPB; const bool isctx = t < CTXL; const int tl = t - CTXL;
            const float pos = (float)(axis ? (tl & 63) : (tl >> 6));
            float s0 = 0.f, c0 = 1.f, s1 = 0.f, c1 = 1.f;
            if (!isctx) { const float a0 = pos * inv0, a1 = pos * inv1; s0 = __sinf(a0); c0 = __cosf(a0); s1 = __sinf(a1); c1 = __cosf(a1); }
            for (int which = 0; which < 2; ++which) {
                bf16_t* base = (bf16_t*)(ws + (which ? WS_KB : WS_QB)) + (size_t)row * 1024;
                const float* gvec = PRM.in[which ? I_KG : I_QG] + (size_t)l * 64; const float g0 = gvec[d0], g1 = gvec[d0 + 1];
                unsigned wv[8];
#pragma unroll
                for (int it = 0; it < 8; ++it) wv[it] = *(const unsigned*)(base + it * 128 + lane * 2);
#pragma unroll
                for (int it = 0; it < 8; ++it) { const unsigned w = wv[it];
                    const float x0 = bf2f(w & 0xffff), x1 = bf2f(w >> 16); float ss = x0 * x0 + x1 * x1;
#pragma unroll
                    for (int s = 1; s < 32; s <<= 1) ss += __shfl_xor(ss, s);
                    const float rs = rsqrtf(ss * (1.f / 64.f) + EPS); float y0 = x0 * rs * g0, y1 = x1 * rs * g1;
                    const float p0 = __shfl_xor(y0, 8), p1 = __shfl_xor(y1, 8);
                    if (!isctx) { y0 = y0 * c0 + sgn * p0 * s0; y1 = y1 * c1 + sgn * p1 * s1; }
                    if (which == 0) { y0 *= QSCALE; y1 *= QSCALE; }
                    wv[it] = pk2(y0, y1); }
#pragma unroll
                for (int it = 0; it < 8; ++it) *(unsigned*)(base + it * 128 + lane * 2) = wv[it];
            }
        }
    }
    for (int u = bx; u < NB * NCH * 8; u += G) { const int h = u & 7, kt = (u >> 3) % NCH, b = u / (8 * NCH);
        tr_unit(lds, (const bf16_t*)(ws + WS_VB) + ((size_t)b * TPB + (size_t)kt * 64) * 1024 + h * 128, 1024,
                (bf16_t*)(ws + WS_VT) + ((size_t)(b * 8 + h) * 128) * TPB + (size_t)kt * 64, TPB, true); }
    for (int u = bx; u < NB * 4 * 4; u += G) { const int cgp = u & 3, kt = (u >> 2) & 3, b = u >> 4;
        const bf16_t* src = (const bf16_t*)(ws + WS_P2) + ((size_t)b * TPB + (size_t)kt * 64) * P2W + 1536 + cgp * 128;
        tr_unit(lds, src, P2W, (bf16_t*)(ws + WS_UTC) + ((size_t)(b * 512 + cgp * 128)) * 256 + kt * 64, 256, false); }
    for (int u = bx; u < NB * 64 * 4; u += G) { const int cgp = u & 3, bb = (u >> 2) & 63, b = u >> 8;
        const bf16_t* src = (const bf16_t*)(ws + WS_P2) + ((size_t)b * TPB + CTXL + bb) * P2W + 1536 + cgp * 128;
        bf16_t* dst = (bf16_t*)(ws + WS_UTL) + ((size_t)(b * 512 + cgp * 128) * 64 + bb) * 128;
#pragma unroll
        for (int i = 0; i < 4; ++i) { const int id = i * 512 + tid, row = id >> 4, c = id & 15;
            *(LAS u32x4*)(lds + row * 272 + c * 16) = *(const u32x4*)(src + (size_t)row * 64 * P2W + c * 8); }
        __syncthreads();
#pragma unroll
        for (int i = 0; i < 4; ++i) { const int id = i * 512 + tid, j = id >> 4, c = id & 15; unsigned e[8];
#pragma unroll
            for (int q = 0; q < 8; ++q) e[q] = *(const LAS unsigned short*)(lds + (8 * c + q) * 272 + j * 2);
            u32x4 o; o.x = e[0] | (e[1] << 16); o.y = e[2] | (e[3] << 16); o.z = e[4] | (e[5] << 16); o.w = e[6] | (e[7] << 16);
            *(u32x4*)(dst + (size_t)j * 8192 + c * 8) = o; }
        __syncthreads(); }
    for (int u = bx; u < NB * 4 * NCH; u += G) { const int c = u % NCH, h = (u / NCH) & 3, b = u / (4 * NCH); gla_g1_unit(lds, l, b, h, c); }
}

#define XB_TMO      128
#define XB_XCNT(j)  (256  + 64 * (j))
#define XB_XSUB(j)  (1280 + 64 * (j))
#define XB_XGEN(j)  (2304 + 64 * (j))
#define XB_TOP      3328
#define XB_TOPGEN   3392
#define XCD_BAR_WORDS 3456
#define XB_SPIN_CAP (1u << 18)
DI unsigned xb_ld(unsigned* p)              { return __hip_atomic_load(p, __ATOMIC_RELAXED, __HIP_MEMORY_SCOPE_AGENT); }
DI unsigned xb_add(unsigned* p, unsigned v) { return __hip_atomic_fetch_add(p, v, __ATOMIC_RELAXED, __HIP_MEMORY_SCOPE_AGENT); }
DI unsigned xb_xcc_id() { return (unsigned)__builtin_amdgcn_s_getreg((3 << 11) | 20) & 0xFu; }
#define XB_SPIN(cond, bar) do { unsigned _sp = 0; while (cond) { __builtin_amdgcn_s_sleep(1); \
    if ((++_sp & 255u) == 0u) { if (xb_ld(&(bar)[XB_TMO])) break; if (_sp > XB_SPIN_CAP) { atomicAdd(&(bar)[XB_TMO], 1u); break; } } } } while (0)
struct XcdBarrier { unsigned* bar; unsigned x; volatile LAS unsigned* st; };
DI void xcd_barrier_post(unsigned* bar) { if (threadIdx.x == 0) (void)xb_add(&bar[XB_XCNT(xb_xcc_id())], 1u); }
DI void xcd_barrier_complete(unsigned* bar, unsigned x, unsigned& nloc, unsigned& nx) {
    const unsigned G = gridDim.x * gridDim.y * gridDim.z;
    unsigned sum, cnt, mine, sp = 0u;
    for (;;) {
        sum = 0u; cnt = 0u; mine = 0u;
#pragma unroll
        for (unsigned j = 0; j < 16; ++j) { const unsigned c = xb_ld(&bar[XB_XCNT(j)]); sum += c; cnt += (c > 0u) ? 1u : 0u; mine = (j == x) ? c : mine; }
        if (sum == G) break;
        __builtin_amdgcn_s_sleep(1);
        if ((++sp & 255u) == 0u) { if (xb_ld(&bar[XB_TMO])) break; if (sp > XB_SPIN_CAP) { atomicAdd(&bar[XB_TMO], 1u); break; } }
    }
    nloc = mine > 0u ? mine : 1u; nx = cnt > 0u ? cnt : 1u;
}
DI void xcd_barrier(const XcdBarrier& b) {
    asm volatile("s_waitcnt vmcnt(0)" ::: "memory");
    __syncthreads();
    if (threadIdx.x == 0) {
        unsigned* bar = b.bar;
        __builtin_amdgcn_s_waitcnt(0);
        unsigned nloc = b.st[0], nx = b.st[1];
        if (nloc == 0u) { xcd_barrier_complete(bar, b.x, nloc, nx); b.st[0] = nloc; b.st[1] = nx; }
        const unsigned old = xb_add(&bar[XB_XSUB(b.x)], 1u);
        const unsigned gen = old / nloc;
        if (old + 1u == (gen + 1u) * nloc) {
            __builtin_amdgcn_fence(__ATOMIC_RELEASE, "agent");
            asm volatile("s_waitcnt vmcnt(0)" ::: "memory");
            const unsigned og = xb_add(&bar[XB_TOP], 1u);
            const unsigned tg = og / nx;
            if (og + 1u == (tg + 1u) * nx) xb_add(&bar[XB_TOPGEN], 1u);
            else XB_SPIN(xb_ld(&bar[XB_TOPGEN]) == tg, bar);
            __builtin_amdgcn_fence(__ATOMIC_ACQUIRE, "agent");
            xb_add(&bar[XB_XGEN(b.x)], 1u);
            asm volatile("s_waitcnt vmcnt(0)" ::: "memory");
        } else {
            XB_SPIN(xb_ld(&bar[XB_XGEN(b.x)]) == gen, bar);
            __builtin_amdgcn_fence(__ATOMIC_ACQUIRE, "agent");
            asm volatile("s_waitcnt vmcnt(0)" ::: "memory");
        }
    }
    __syncthreads();
}

__global__ void __launch_bounds__(512, 2) mega(Params p_unused) {
    extern __shared__ __attribute__((aligned(16))) unsigned char lds_raw[];
    LAS unsigned char* lds = (LAS unsigned char*)lds_raw;
    cg::grid_group grid = cg::this_grid();
    #define RUN(k) (PRM.ph_lo <= (k) && (k) < PRM.ph_hi)
#define SEAM_ALWAYS() do { XcdBarrier xb_{(unsigned*)(LP(PRM.ws) + WS_BAR), xb_xcc_id(), (volatile LAS unsigned*)(lds + LDS_BYTES - 16)}; xcd_barrier(xb_); } while (0)
#define SEAM(k) do { if (PRM.coop && RUN(k) && RUN((k) + 1)) { XcdBarrier xb_{(unsigned*)(LP(PRM.ws) + WS_BAR), xb_xcc_id(), (volatile LAS unsigned*)(lds + LDS_BYTES - 16)}; xcd_barrier(xb_); } } while (0)
    if (PRM.coop == 2) grid.sync();
    { volatile LAS unsigned* stw = (volatile LAS unsigned*)(lds + LDS_BYTES - 16); if (threadIdx.x == 0) { stw[0] = 0u; stw[1] = 0u; } __syncthreads();
      if (PRM.coop) xcd_barrier_post((unsigned*)(LP(PRM.ws) + WS_BAR)); }
#if REPK == 20
    if (PRM.coop) for (int i = 0; i < 20; ++i) SEAM_ALWAYS();
#endif
    for (int l = 0; l < 2; ++l) {
        const int P = l * 10;
        const bool last = (l == 1);
        const float lam_init = 0.8f - 0.6f * __expf(-0.3f * (float)l);
#ifndef NO_PREP
        if (RUN(P + 0)) for (int rep = 0; rep < NREP(0); ++rep) phase_prep(lds, l);
#endif
        if (l == 0) SEAM(P + 0);
        if (RUN(P + 1)) for (int rep = 0; rep < NREP(1); ++rep) phase_norm(l, 0, false, l == 1 ? 2 : 0, 0, 5, l == 0 ? (const void*)PRM.in[I_X] : (const void*)PRM.out, l == 0 ? 0 : 1);
        SEAM(P + 1);
        if (RUN(P + 2)) for (int rep = 0; rep < NREP(2); ++rep) {
            pg8::Gemm g{(const bf16_t*)(LP(PRM.ws) + WS_A), (const bf16_t*)(LP(PRM.ws) + WS_WIN), DM, DM, DM};
            pg8::Order S; S.init(MROWS / 256, NIN / 256, GDIM(), BID(), 0);
            pg8::EpiBf16<0> E{(bf16_t*)(LP(PRM.ws) + WS_QB), 1024, 1};
            pg8::gemm_phase(lds, g, S, E);
        }
        SEAM(P + 2);
#ifndef NO_POST
        if (RUN(P + 3)) for (int rep = 0; rep < NREP(3); ++rep) phase_post(lds, l, rep == 0);
#endif
        SEAM(P + 3);
        if (RUN(P + 4)) {
            gla_scan();
#if REPK == 11
            if (l == 0) { SEAM_ALWAYS(); for (int u = BID(); u < NB * 4 * NCH; u += GDIM()) { const int c = u % NCH, h = (u / NCH) & 3, b = u / (4 * NCH); gla_g1_unit(lds, l, b, h, c); } SEAM_ALWAYS(); gla_scan(); }
#endif
#if REPK == 12
            if (l == 0) { SEAM_ALWAYS(); for (int u = BID(); u < NB * 4 * NCH; u += GDIM()) { const int c = u % NCH, h = (u / NCH) & 3, b = u / (4 * NCH); gla_g1_unit(lds, l, b, h, c); } SEAM_ALWAYS(); }
#endif
            for (int rep = 0; rep < NREP(4); ++rep) {
            {
                pg8::Gemm g{(const bf16_t*)(LP(PRM.ws) + WS_A1), (const bf16_t*)(LP(PRM.ws) + WS_UTL), 128, 128, 128};
                pg8::Order S; S.init(1, 256, GDIM(), BID(), 0);
                pg8::EpiDft1 E{(bf16_t*)(LP(PRM.ws) + WS_B2T)};
                pg8::gemm_phase(lds, g, S, E);
            }
            if (!last) {
                pg8::Gemm g{(const bf16_t*)(LP(PRM.ws) + WS_TCTX), (const bf16_t*)(LP(PRM.ws) + WS_UTC), 256, 256, 256};
                pg8::Order S; S.init(2, 4, 8, BID() - 116, 0);
                pg8::EpiDftCtx E{(bf16_t*)(LP(PRM.ws) + WS_PQ)};
                pg8::gemm_phase(lds, g, S, E);
            }
            __syncthreads();
            if (PRM.coop) SEAM_ALWAYS();
            {
                pg8::Gemm g{(const bf16_t*)(LP(PRM.ws) + WS_A2), (const bf16_t*)(LP(PRM.ws) + WS_B2T), 128, 128, 128};
                pg8::Order S; S.init(1, 512, GDIM(), BID(), 0);
                pg8::EpiDft2 E{(bf16_t*)(LP(PRM.ws) + WS_PQ)};
                pg8::gemm_phase(lds, g, S, E);
            }
            __syncthreads();
#ifndef NO_ATT
            {
                const float* qg = PRM.in[I_QG] + l * 64; const float* kgv = PRM.in[I_KG] + l * 64; const float* lp = PRM.in[I_LAM] + l * 256;
                float mq = 0.f, mk = 0.f, s01 = 0.f, s23 = 0.f;
                for (int i = 0; i < 64; ++i) { mq = fmaxf(mq, fabsf(qg[i])); mk = fmaxf(mk, fabsf(kgv[i])); s01 += lp[i] * lp[64 + i]; s23 += lp[128 + i] * lp[192 + i]; }
                const float shift2 = 8.f * mq * mk * LOG2E * 1.02f;
                const float lam = __builtin_bit_cast(float, __builtin_amdgcn_readfirstlane(__builtin_bit_cast(int, __expf(s01) - __expf(s23) + lam_init)));
                const int lam_init_bits = __builtin_amdgcn_readfirstlane(__builtin_bit_cast(int, lam_init));
                const int nun = last ? 512 : 528;
                const int G = GDIM(), bx = BID(); const int vcu = (G % 8 == 0) ? (bx % 8) * (G / 8) + bx / 8 : bx;
                for (int u = vcu; u < nun; u += G) {
                    int b, h, qt;
                    if (u < 512) { b = u >> 8; h = (u >> 5) & 7; qt = (u & 31) + 1; } else { const int v = u - 512; b = v >> 3; h = v & 7; qt = 0; }
                    att::attn_unit<false>(lds, (const bf16_t*)(LP(PRM.ws) + WS_QB), (const bf16_t*)(LP(PRM.ws) + WS_KB), (const bf16_t*)(LP(PRM.ws) + WS_VT), (bf16_t*)(LP(PRM.ws) + WS_A), b, h, qt, 0.f, lam, lam_init_bits, PRM.in[I_SUBLN] + l * 128);
                }
            }
#endif
            }
        }
        SEAM(P + 4);
        if (RUN(P + 5)) {
#ifndef NO_G3
            { const int G_ = GDIM(), bx_ = BID(); const int nlat = NB * 4 * 128;
              for (int u = bx_; ; u += G_) { int b, h, c;
                  if (u < nlat) { c = 4 + (u & 127); h = (u >> 7) & 3; b = u >> 9; }
                  else { const int v = bx_ - (G_ - 32); if (last || v < 0) break; c = v & 3; h = (v >> 2) & 3; b = (v >> 4) & 1; }
                  gla_g3_unit(lds, l, b, h, c);
                  if (u >= nlat) break; } }
#endif
            __syncthreads();
            {
                pg8::Gemm g{(const bf16_t*)(LP(PRM.ws) + WS_PQ), (const bf16_t*)(LP(PRM.ws) + WS_WCS), 1024, 1024, 1024};
                pg8::Order S; if (last) S.init(64, 2, GDIM(), BID(), 1); else S.init(66, 2, GDIM(), BID(), 0);
                pg8::EpiBf16<0> E{(bf16_t*)(LP(PRM.ws) + WS_A) + 1536, DM, 0};
                pg8::gemm_phase(lds, g, S, E);
            }
        }
        SEAM(P + 5);
        if (RUN(P + 6)) for (int rep = 0; rep < NREP(6); ++rep) {
            pg8::Gemm g{(const bf16_t*)(LP(PRM.ws) + WS_A), (const bf16_t*)(LP(PRM.ws) + WS_WOUT), DM, DM, DM};
            pg8::Order S; S.init(64, 8, GDIM(), BID(), 1);
            pg8::EpiResid E{l == 0 ? (const void*)PRM.in[I_X] : (const void*)PRM.out, l == 0 ? (void*)PRM.out : (void*)(LP(PRM.ws) + WS_KV), (const float*)(LP(PRM.ws) + WS_MOD) + (size_t)l * 3 * 12288 + 2 * DM, l == 0 ? 0 : 1, 1};
            pg8::gemm_phase(lds, g, S, E);
            if (!last) {
                pg8::Gemm g2{(const bf16_t*)(LP(PRM.ws) + WS_A), (const bf16_t*)(LP(PRM.ws) + WS_WOUT), DM / NSPLIT, DM, DM};
                pg8::Order S2; S2.init(2, 8, GDIM(), BID(), 2, NSPLIT, DM / NSPLIT);
                pg8::EpiPartial E2{(float*)(LP(PRM.ws) + WS_PART), DM / NSPLIT};
                pg8::gemm_phase(lds, g2, S2, E2);
            }
        }
        SEAM(P + 6);
        if (RUN(P + 7)) phase_norm(l, 1, last, last ? 0 : 1, l, 2, l == 0 ? (const void*)PRM.out : (const void*)(LP(PRM.ws) + WS_KV), 1);
        SEAM(P + 7);
        if (RUN(P + 8)) for (int rep = 0; rep < NREP(8); ++rep) {
            pg8::Gemm g{(const bf16_t*)(LP(PRM.ws) + WS_A), (const bf16_t*)(LP(PRM.ws) + WS_WFF1), DM, DM, DM};
            pg8::Order S; if (last) S.init(64, 32, GDIM(), BID(), 1); else S.init(66, 32, GDIM(), BID(), 0);
            pg8::EpiBf16<1> E{(bf16_t*)(LP(PRM.ws) + WS_H), DFF, 0};
            pg8::gemm_phase(lds, g, S, E);
        }
        SEAM(P + 8);
        if (RUN(P + 9)) {
            pg8::Gemm g{(const bf16_t*)(LP(PRM.ws) + WS_H), (const bf16_t*)(LP(PRM.ws) + WS_WFF2), DFF, DFF, DFF};
            pg8::Order S; S.init(64, 8, GDIM(), BID(), 1);
            pg8::EpiResid E{l == 0 ? (const void*)PRM.out : (const void*)(LP(PRM.ws) + WS_KV), (void*)PRM.out, (const float*)(LP(PRM.ws) + WS_MOD) + (size_t)l * 3 * 12288 + 5 * DM, 1, l == 0 ? 1 : 0};
            pg8::gemm_phase(lds, g, S, E);
            if (NREP(9) == 2) {
                pg8::Gemm g3{(const bf16_t*)(LP(PRM.ws) + WS_H), (const bf16_t*)(LP(PRM.ws) + WS_WFF2), DFF, DFF, DFF};
                pg8::Order S3; S3.init(64, 8, GDIM(), BID(), 1);
                pg8::EpiBf16<0> E3{(bf16_t*)(LP(PRM.ws) + WS_T + ((size_t)64 << 20)), DM, 0};
                pg8::gemm_phase(lds, g3, S3, E3);
            }
            if (!last) {
                pg8::Gemm g2{(const bf16_t*)(LP(PRM.ws) + WS_H), (const bf16_t*)(LP(PRM.ws) + WS_WFF2), DFF / NSPLIT, DFF, DFF};
                pg8::Order S2; S2.init(2, 8, GDIM(), BID(), 2, NSPLIT, DFF / NSPLIT);
                pg8::EpiPartial E2{(float*)(LP(PRM.ws) + WS_PART), DFF / NSPLIT};
                pg8::gemm_phase(lds, g2, S2, E2);
            }
        }
        SEAM(P + 9);
    }
}

extern "C" void kernel_launch(void* const* d_in, const int* in_sizes, int n_in, void* d_out, int out_size, void* d_ws, size_t ws_size, hipStream_t stream) {
    static int grid = 0;
    if (grid == 0) {
        if (n_in != 20 || out_size != NB * SEQ * DM || ws_size < WS_END) { fprintf(stderr, "kernel_launch: unexpected problem (n_in %d out %d ws %zu need %zu)\n", n_in, out_size, ws_size, (size_t)WS_END); grid = -1; return; }
        int dev = 0, cus = 0, per_cu = 0;
        hipGetDevice(&dev); hipDeviceGetAttribute(&cus, hipDeviceAttributeMultiprocessorCount, dev);
        if (hipFuncSetAttribute((const void*)mega, hipFuncAttributeMaxDynamicSharedMemorySize, LDS_BYTES) != hipSuccess) { fprintf(stderr, "kernel_launch: hipFuncSetAttribute failed\n"); grid = -1; return; }
        if (hipOccupancyMaxActiveBlocksPerMultiprocessor(&per_cu, (const void*)mega, 512, LDS_BYTES) != hipSuccess || per_cu < 1) { fprintf(stderr, "kernel_launch: occupancy query says %d\n", per_cu); per_cu = 1; }
        (void)hipGetLastError();
        grid = cus;
    }
    if (grid < 0) return;
    Params p{};
    for (int i = 0; i < 20; ++i) p.in[i] = (const float*)d_in[i];
    p.out = (float*)d_out; p.ws = (unsigned char*)d_ws; p.ph_lo = 0; p.ph_hi = 20; p.coop = 1; p.pad = 0;
    if (hipMemsetAsync((char*)d_ws + WS_BAR, 0, 16384, stream) != hipSuccess) { fprintf(stderr, "kernel_launch: memset of barrier words failed\n"); return; }
    void* args[] = {&p};
    hipError_t e = hipLaunchCooperativeKernel((const void*)mega, dim3(grid), dim3(512), args, LDS_BYTES, stream);
    if (e != hipSuccess) fprintf(stderr, "cooperative launch failed: %s (grid %d)\n", hipGetErrorString(e), grid);
}
```

```cpp
#include <hip/hip_runtime.h>
#include <hip/hip_cooperative_groups.h>
#include <cstdio>
#include <cstdint>
namespace cg = cooperative_groups;

#define LAS __attribute__((address_space(3)))
typedef unsigned short bf16_t;
typedef short bf16x8 __attribute__((ext_vector_type(8)));
typedef float f32x4 __attribute__((ext_vector_type(4)));
typedef float f32x16 __attribute__((ext_vector_type(16)));
typedef unsigned u32x4 __attribute__((ext_vector_type(4)));
typedef unsigned u32x2 __attribute__((ext_vector_type(2)));
#define DI __device__ __forceinline__
#define LDS_WAIT() asm volatile("s_waitcnt lgkmcnt(0)" ::: "memory")

constexpr int DM = 2048, NB = 2, SEQ = 8192, CTXL = 256, TPB = SEQ + CTXL  , MROWS = NB * TPB  ;
constexpr int DIN = 5152, NIN = 5376, DFF = 8192, P2W = 2304, NCH = TPB / 64  ;
constexpr float EPS = 1e-6f;
constexpr float QSCALE = 0.18033688011112042f;
constexpr float LOG2E = 1.4426950408889634f;

constexpr size_t al256(size_t x) { return (x + 255) & ~(size_t)255; }
constexpr size_t WS_MOD = 0;
constexpr size_t WS_XC = al256(WS_MOD + (size_t)2 * 3 * 12288 * 4);
constexpr size_t WS_WIN = al256(WS_XC + (size_t)512 * DM * 4);
constexpr size_t WS_WOUT = al256(WS_WIN + (size_t)NIN * DM * 2);
constexpr size_t WS_WFF1 = al256(WS_WOUT + (size_t)DM * DM * 2);
constexpr size_t WS_WFF2 = al256(WS_WFF1 + (size_t)DFF * DM * 2);
constexpr size_t WS_WCS = al256(WS_WFF2 + (size_t)DM * DFF * 2);
constexpr size_t WS_TCTX = al256(WS_WCS + (size_t)512 * 1024 * 2);
constexpr size_t WS_A = al256(WS_TCTX + (size_t)512 * 256 * 2);
constexpr size_t WS_QB = al256(WS_A + (size_t)MROWS * DM * 2);
constexpr size_t WS_KB = al256(WS_QB + (size_t)MROWS * 1024 * 2);
constexpr size_t WS_VB = al256(WS_KB + (size_t)MROWS * 1024 * 2);
constexpr size_t WS_VT = al256(WS_VB + (size_t)MROWS * 1024 * 2);
constexpr size_t WS_P2 = al256(WS_VT + (size_t)MROWS * 1024 * 2);
constexpr size_t WS_T = al256(WS_P2 + (size_t)MROWS * P2W * 2);
constexpr size_t WS_B2T = WS_T;
constexpr size_t WS_A1 = WS_T + ((size_t)100 << 20);
constexpr size_t WS_A2 = WS_A1 + 65536;
constexpr size_t WS_H = WS_QB;
constexpr size_t WS_UTL = al256(WS_T + (size_t)8448 * 8192 * 2);
constexpr size_t WS_UTC = al256(WS_UTL + (size_t)1024 * 8192 * 2);
constexpr size_t WS_PQ = al256(WS_UTC + (size_t)1024 * 256 * 2);
constexpr size_t WS_KV = al256(WS_PQ + (size_t)MROWS * 1024 * 2);
constexpr size_t WS_DEC = al256(WS_KV + (size_t)16 * NCH * 8192 * 4);
constexpr size_t WS_PART = al256(WS_DEC + (size_t)16 * NCH * 64 * 4);
constexpr size_t WS_BAR = al256(WS_PART + (size_t)8 * 512 * DM * 4);
constexpr size_t WS_END = WS_BAR + 16384;
constexpr int NSPLIT = 8;
static_assert(WS_H + (size_t)MROWS * DFF * 2 <= WS_UTL, "H overlay must end before UTL");
static_assert(WS_KB - WS_QB == (size_t)MROWS * 2048 && WS_VB - WS_KB == (size_t)MROWS * 2048 && WS_P2 - WS_QB == 4 * (size_t)MROWS * 2048, "in-proj destinations at fixed strides");

constexpr int LDS_BYTES = 160768;
#ifndef REPK
#define REPK -1
#endif
#define NREP(k) ((l == 0 && (k) == REPK) ? 2 : 1)

DI unsigned f2bf(float f) { unsigned u = __builtin_bit_cast(unsigned, f); return (u + 0x7fffu + ((u >> 16) & 1u)) >> 16; }
DI unsigned pk2(float lo, float hi) { return f2bf(lo) | (f2bf(hi) << 16); }
DI float bf2f(unsigned h) { return __builtin_bit_cast(float, h << 16); }
DI unsigned cvt_pk_bf16(float lo, float hi) { unsigned r; asm volatile("v_cvt_pk_bf16_f32 %0, %1, %2" : "=v"(r) : "v"(lo), "v"(hi)); return r; }
DI int TID() { int t = threadIdx.x; asm volatile("" : "+v"(t)); return t; }
DI int BID() { int t = blockIdx.x; asm volatile("" : "+s"(t)); return t; }
DI int GDIM() { int t = gridDim.x; asm volatile("" : "+s"(t)); return t; }
template <class T> DI T* LP(T* p) { asm volatile("" : "+s"(p)); return p; }
DI float wave_sum(float v) {
#pragma unroll
    for (int o = 1; o < 64; o <<= 1) v += __shfl_xor(v, o);
    return v;
}
DI float logsig(float z) { return fminf(z, 0.f) - __logf(1.f + __expf(-fabsf(z))); }

namespace pg8 {
constexpr int BM = 256, BK = 64, HALF = 128, HTB = HALF * BK * 2, STAGE_BYTES = 8 * HTB, NXCD = 8, WGM = 8;
DI int lds_byte(int r, int c) { const int st = (r >> 4) * 2 + (c >> 5), rr = r & 15, cc = c & 31, ob = rr * 64 + cc * 2; return st * 1024 + (ob ^ (((ob >> 9) & 1) << 5)); }
DI void stage_rc(int b, int& R, int& C) { const int st = b / 1024, sb = b % 1024, swz = sb ^ (((sb >> 9) & 1) << 5); R = (st >> 1) * 16 + swz / 64; C = (st & 1) * 32 + (swz % 64) / 2; }
DI int perm32(int rho) { const int n = rho >> 4, i = rho & 15; return 8 * (i >> 2) + 4 * n + (i & 3); }
struct Unit { int pm, pn, ko; };
struct Gemm { const bf16_t* A; const bf16_t* Bt; int K, lda, ldb; };
struct Order {
    int nM, nN, nwg, G, c, skip, nK, ksub;
    DI void init(int nM_, int nN_, int G_, int c_, int skip_, int nK_ = 1, int ksub_ = 0) { nM = nM_; nN = nN_; nwg = nM * nN; G = G_; c = c_; skip = skip_; nK = nK_; ksub = ksub_; }
    DI bool next(int i, Unit& u) const {
        if (c < 0 || c >= G) return false;
        const int L = i * G + c; if (L >= nwg * nK) return false;
        int wgid = L % nwg; u.ko = (L / nwg) * ksub;
        { const int q = nwg / NXCD, r = nwg % NXCD, xcd = wgid % NXCD, off = wgid / NXCD; wgid = (xcd < r ? xcd * (q + 1) : r * (q + 1) + (xcd - r) * q) + off; }
        const int nig = WGM * nN, gid = wgid / nig, fm = gid * WGM, gsz = (nM - fm) < WGM ? (nM - fm) : WGM;
        int pm = fm + ((wgid % nig) % gsz); u.pn = (wgid % nig) / gsz;
        if (skip == 1) pm = pm + 1 + (pm >= 32 ? 1 : 0);
        if (skip == 2) pm = pm * 33;
        u.pm = pm; return true;
    }
};

template <class Epi>
DI void gemm_phase(LAS unsigned char* lds, const Gemm g, const Order& S, const Epi& E) {
    const int tid = TID(), wid = __builtin_amdgcn_readfirstlane(tid >> 6), lane = tid & 63, wr = wid >> 2, wc = wid & 3, fr = lane & 15, fq = lane >> 4;
    int K = g.K; asm volatile("" : "+s"(K));
    const int nt = K / BK;
    unsigned voffA[2], voffB[2];
#pragma unroll
    for (int i = 0; i < 2; ++i) { int R, C; stage_rc(tid * 16 + i * 8192, R, C); const int Rb = Epi::PERM ? ((R & ~31) + perm32(R & 31)) : R;
        voffA[i] = (unsigned)(R * g.lda + C) * 2u; voffB[i] = (unsigned)(Rb * g.ldb + C) * 2u; }
    const size_t kstep = (size_t)(BK * 2);
    const size_t hstepA = (size_t)HALF * g.lda * 2, hstepB = (size_t)HALF * g.ldb * 2;
    const size_t tstepA = 2 * hstepA, tstepB = 2 * hstepB;
    const unsigned ldsw = (unsigned)wid * 1024u;
    const int aoff = lds_byte(wr * 64 + fr, fq * 8), boff = lds_byte(wc * 32 + fr, fq * 8);
#define PG8_SA(b, h) (((b) * 2 + (h)) * HTB)
#define PG8_SB(b, h) ((4 + (b) * 2 + (h)) * HTB)
#define PG8_STAGE(bufoff, gbase, voff) do { _Pragma("unroll") for (int _i = 0; _i < 2; ++_i) \
        __builtin_amdgcn_global_load_lds((const unsigned*)((const char*)(gbase) + (voff)[_i]), (LAS unsigned*)(lds + (bufoff) + ldsw + _i * 8192), 16, 0, 0); } while (0)
#define PG8_LDA(dst, b, h) do { _Pragma("unroll") for (int m = 0; m < 4; ++m) _Pragma("unroll") for (int k = 0; k < 2; ++k) dst[m][k] = *(const LAS bf16x8*)(lds + PG8_SA(b, h) + aoff + m * 2048 + k * 1024); } while (0)
#define PG8_LDB(dst, b, h) do { _Pragma("unroll") for (int n = 0; n < 2; ++n) _Pragma("unroll") for (int k = 0; k < 2; ++k) dst[n][k] = *(const LAS bf16x8*)(lds + PG8_SB(b, h) + boff + n * 2048 + k * 1024); } while (0)
#define PG8_MMA(ai, bj, At, Bt) do { __builtin_amdgcn_s_setprio(1); _Pragma("unroll") for (int m = 0; m < 4; ++m) _Pragma("unroll") for (int n = 0; n < 2; ++n) _Pragma("unroll") for (int k = 0; k < 2; ++k) \
        acc[ai][bj][m][n] = __builtin_amdgcn_mfma_f32_16x16x32_bf16(Bt[n][k], At[m][k], acc[ai][bj][m][n], 0, 0, 0); __builtin_amdgcn_s_setprio(0); } while (0)
#define PG8_WAIT_V(n) asm volatile("s_waitcnt vmcnt(" #n ")" ::: "memory")
#define PG8_WAIT_L(n) asm volatile("s_waitcnt lgkmcnt(" #n ")" ::: "memory")
#define PG8_BAR __builtin_amdgcn_s_barrier()
#define PG8_SCHED __builtin_amdgcn_sched_barrier(0)
    Unit cur, nxt; int ui = 0;
    if (!S.next(0, cur)) return;
    f32x4 acc[2][2][4][2];
#pragma unroll
    for (int a = 0; a < 2; ++a)
#pragma unroll
        for (int b = 0; b < 2; ++b)
#pragma unroll
            for (int m = 0; m < 4; ++m)
#pragma unroll
                for (int n = 0; n < 2; ++n) acc[a][b][m][n] = (f32x4){0.f, 0.f, 0.f, 0.f};
    bf16x8 At[4][2], B0[2][2], B1[2][2];
    const char* cA = (const char*)g.A + (size_t)cur.pm * tstepA + (size_t)cur.ko * 2; const char* cB = (const char*)g.Bt + (size_t)cur.pn * tstepB + (size_t)cur.ko * 2;
    PG8_STAGE(PG8_SB(0, 0), cB, voffB); PG8_STAGE(PG8_SB(0, 1), cB + hstepB, voffB); PG8_STAGE(PG8_SA(0, 0), cA, voffA); PG8_STAGE(PG8_SA(0, 1), cA + hstepA, voffA);
    if (wr == 1) PG8_BAR;
    PG8_WAIT_V(2); PG8_BAR;
    PG8_STAGE(PG8_SB(1, 0), cB + kstep, voffB); PG8_STAGE(PG8_SA(1, 0), cA + kstep, voffA); PG8_STAGE(PG8_SB(1, 1), cB + hstepB + kstep, voffB);
    PG8_WAIT_V(6); PG8_BAR;
    for (;;) {
        const bool has_next = S.next(ui + 1, nxt);
        const char* nA = has_next ? (const char*)g.A + (size_t)nxt.pm * tstepA + (size_t)nxt.ko * 2 : cA; const char* nB = has_next ? (const char*)g.Bt + (size_t)nxt.pn * tstepB + (size_t)nxt.ko * 2 : cB;
        for (int t = 0; t < nt; t += 2) {
            const bool last = (t == nt - 2);
            const char* a1 = cA + (size_t)(t + 1) * kstep;
            const char* a2 = last ? nA : cA + (size_t)(t + 2) * kstep; const char* b2 = last ? nB : cB + (size_t)(t + 2) * kstep;
            const char* a3 = a2 + kstep; const char* b3 = b2 + kstep;
            PG8_LDB(B0, 0, 0); PG8_LDB(B1, 0, 1); PG8_SCHED; PG8_LDA(At, 0, 0); PG8_STAGE(PG8_SA(1, 1), a1 + hstepA, voffA);
            PG8_WAIT_V(8); PG8_WAIT_L(0); PG8_BAR; PG8_MMA(0, 0, At, B0); PG8_MMA(0, 1, At, B1); PG8_BAR; PG8_SCHED;
            PG8_LDA(At, 0, 1); PG8_STAGE(PG8_SB(0, 0), b2, voffB); PG8_STAGE(PG8_SB(0, 1), b2 + hstepB, voffB); PG8_STAGE(PG8_SA(0, 0), a2, voffA);
            PG8_WAIT_V(8); PG8_WAIT_L(0); PG8_BAR; PG8_MMA(1, 0, At, B0); PG8_MMA(1, 1, At, B1); PG8_BAR; PG8_SCHED;
            PG8_LDB(B0, 1, 0); PG8_LDB(B1, 1, 1); PG8_SCHED; PG8_LDA(At, 1, 0); PG8_STAGE(PG8_SA(0, 1), a2 + hstepA, voffA);
            PG8_WAIT_V(8); PG8_WAIT_L(0); PG8_BAR; PG8_MMA(0, 0, At, B0); PG8_MMA(0, 1, At, B1); PG8_BAR; PG8_SCHED;
            PG8_LDA(At, 1, 1); PG8_STAGE(PG8_SB(1, 0), b3, voffB); PG8_STAGE(PG8_SB(1, 1), b3 + hstepB, voffB); PG8_STAGE(PG8_SA(1, 0), a3, voffA);
            PG8_WAIT_V(8); PG8_WAIT_L(0); PG8_BAR; PG8_MMA(1, 0, At, B0); PG8_MMA(1, 1, At, B1); PG8_BAR; PG8_SCHED;
        }
        if (wr == 0) PG8_BAR;
        E(acc, cur, wr, wc, fr, fq);
        if (!has_next) break;
#pragma unroll
        for (int a = 0; a < 2; ++a)
#pragma unroll
            for (int b = 0; b < 2; ++b)
#pragma unroll
                for (int m = 0; m < 4; ++m)
#pragma unroll
                    for (int n = 0; n < 2; ++n) acc[a][b][m][n] = (f32x4){0.f, 0.f, 0.f, 0.f};
        cur = nxt; cA = nA; cB = nB; ++ui;
        if (wr == 1) PG8_BAR;
    }
    PG8_WAIT_V(0);
    PG8_BAR;
#undef PG8_SA
#undef PG8_SB
#undef PG8_STAGE
#undef PG8_LDA
#undef PG8_LDB
#undef PG8_MMA
#undef PG8_WAIT_V
#undef PG8_WAIT_L
#undef PG8_BAR
#undef PG8_SCHED
}

template <int ACT> struct EpiBf16 {
    static constexpr bool PERM = true;
    bf16_t* d0; int ld0; int split;
    DI void operator()(const f32x4 (&acc)[2][2][4][2], const Unit& u, int wr, int wc, int fr_, int fq_) const {
        int fr = fr_, fq = fq_; asm volatile("" : "+v"(fr), "+v"(fq));
        bf16_t* base = d0; int ldc = ld0, t0 = 0;
        if (split) { const int sg = (u.pn >> 2) < 3 ? (u.pn >> 2) : 3; base = d0 + (size_t)(sg < 3 ? sg : 4) * ((size_t)MROWS * 1024); ldc = sg < 3 ? 1024 : P2W; t0 = sg * 4; }
        const int row0 = u.pm * BM + wr * 64 + fr, col0 = (u.pn - t0) * BM + wc * 32 + 8 * fq;
#pragma unroll
        for (int ai = 0; ai < 2; ++ai)
#pragma unroll
            for (int m = 0; m < 4; ++m) { bf16_t* rowp = base + (size_t)(row0 + ai * HALF + m * 16) * ldc + col0;
#pragma unroll
                for (int bj = 0; bj < 2; ++bj) { f32x4 v0 = acc[ai][bj][m][0], v1 = acc[ai][bj][m][1];
                    if (ACT == 1) {
#pragma unroll
                        for (int j = 0; j < 4; ++j) { const float a = fmaxf(v0[j], 0.f), b = fmaxf(v1[j], 0.f); v0[j] = a * a; v1[j] = b * b; } }
                    u32x4 w; w.x = cvt_pk_bf16(v0[0], v0[1]); w.y = cvt_pk_bf16(v0[2], v0[3]); w.z = cvt_pk_bf16(v1[0], v1[1]); w.w = cvt_pk_bf16(v1[2], v1[3]);
                    *(u32x4*)(rowp + bj * HALF) = w; } }
    }
};
struct EpiResid {
    static constexpr bool PERM = true;
    const void* src; void* dst; const float* gate; int sb, db;
    DI void operator()(const f32x4 (&acc)[2][2][4][2], const Unit& u, int wr, int wc, int fr_, int fq_) const {
        int fr = fr_, fq = fq_; asm volatile("" : "+v"(fr), "+v"(fq));
        const int b = u.pm / 33, tt = u.pm % 33;
        const size_t roff = ((size_t)b * SEQ + (size_t)(tt - 1) * 256) * DM;
        const float* gp = gate + (size_t)b * 12288;
        const int col0 = u.pn * BM + wc * 32 + 8 * fq;
        f32x4 gq[2][2];
#pragma unroll
        for (int bj = 0; bj < 2; ++bj) { gq[bj][0] = *(const f32x4*)(gp + col0 + bj * HALF); gq[bj][1] = *(const f32x4*)(gp + col0 + bj * HALF + 4); }
        if (sb) {
#pragma unroll
            for (int ai = 0; ai < 2; ++ai) {
                u32x4 pre[4][2];
#pragma unroll
                for (int m = 0; m < 4; ++m) { const size_t off = roff + (size_t)(ai * HALF + wr * 64 + m * 16 + fr) * DM + col0;
#pragma unroll
                    for (int bj = 0; bj < 2; ++bj) pre[m][bj] = *(const u32x4*)((const bf16_t*)src + off + bj * HALF); }
#pragma unroll
                for (int m = 0; m < 4; ++m) { const size_t off = roff + (size_t)(ai * HALF + wr * 64 + m * 16 + fr) * DM + col0;
#pragma unroll
                    for (int bj = 0; bj < 2; ++bj) { const int cc = bj * HALF; const u32x4 w = pre[m][bj];
                        const f32x4 s0 = (f32x4){bf2f(w.x & 0xffff), bf2f(w.x >> 16), bf2f(w.y & 0xffff), bf2f(w.y >> 16)}, s1 = (f32x4){bf2f(w.z & 0xffff), bf2f(w.z >> 16), bf2f(w.w & 0xffff), bf2f(w.w >> 16)};
                        const f32x4 o0 = s0 + gq[bj][0] * acc[ai][bj][m][0], o1 = s1 + gq[bj][1] * acc[ai][bj][m][1];
                        if (db) { u32x4 o; o.x = cvt_pk_bf16(o0[0], o0[1]); o.y = cvt_pk_bf16(o0[2], o0[3]); o.z = cvt_pk_bf16(o1[0], o1[1]); o.w = cvt_pk_bf16(o1[2], o1[3]); *(u32x4*)((bf16_t*)dst + off + cc) = o; }
                        else { *(f32x4*)((float*)dst + off + cc) = o0; *(f32x4*)((float*)dst + off + cc + 4) = o1; } } }
                asm volatile("" ::: "memory"); }
        } else {
#pragma unroll
            for (int ai = 0; ai < 2; ++ai)
#pragma unroll
                for (int m = 0; m < 4; ++m) { const size_t off = roff + (size_t)(ai * HALF + wr * 64 + m * 16 + fr) * DM + col0;
#pragma unroll
                    for (int bj = 0; bj < 2; ++bj) { const int cc = bj * HALF;
                        const f32x4 s0 = *(const f32x4*)((const float*)src + off + cc), s1 = *(const f32x4*)((const float*)src + off + cc + 4);
                        const f32x4 o0 = s0 + gq[bj][0] * acc[ai][bj][m][0], o1 = s1 + gq[bj][1] * acc[ai][bj][m][1];
                        if (db) { u32x4 o; o.x = cvt_pk_bf16(o0[0], o0[1]); o.y = cvt_pk_bf16(o0[2], o0[3]); o.z = cvt_pk_bf16(o1[0], o1[1]); o.w = cvt_pk_bf16(o1[2], o1[3]); *(u32x4*)((bf16_t*)dst + off + cc) = o; }
                        else { *(f32x4*)((float*)dst + off + cc) = o0; *(f32x4*)((float*)dst + off + cc + 4) = o1; } }
                    if (m & 1) asm volatile("" ::: "memory"); }
        }
    }
};
struct EpiPartial {
    static constexpr bool PERM = true;
    float* part; int ksub;
    DI void operator()(const f32x4 (&acc)[2][2][4][2], const Unit& u, int wr, int wc, int fr_, int fq_) const {
        int fr = fr_, fq = fq_; asm volatile("" : "+v"(fr), "+v"(fq));
        const int b = u.pm / 33, ks = u.ko / ksub;
        float* dp = part + ((size_t)ks * 512 + (size_t)b * 256) * DM;
        const int col0 = u.pn * BM + wc * 32 + 8 * fq;
#pragma unroll
        for (int ai = 0; ai < 2; ++ai)
#pragma unroll
            for (int m = 0; m < 4; ++m) { float* q = dp + (size_t)(ai * HALF + wr * 64 + m * 16 + fr) * DM + col0;
#pragma unroll
                for (int bj = 0; bj < 2; ++bj) { *(f32x4*)(q + bj * HALF) = acc[ai][bj][m][0]; *(f32x4*)(q + bj * HALF + 4) = acc[ai][bj][m][1]; } }
    }
};
struct EpiDft1 {
    static constexpr bool PERM = false;
    bf16_t* B2t;
    DI void operator()(const f32x4 (&acc)[2][2][4][2], const Unit& u, int wr, int wc, int fr_, int fq_) const {
        int fr = fr_, fq = fq_; asm volatile("" : "+v"(fr), "+v"(fq));
#pragma unroll
        for (int m = 0; m < 4; ++m) { const int c = wr * 64 + m * 16 + fr;
#pragma unroll
            for (int bj = 0; bj < 2; ++bj)
#pragma unroll
                for (int n = 0; n < 2; ++n) { const int nl = bj * HALF + wc * 32 + n * 16 + 4 * fq; const int colg = u.pn * 4 + (nl >> 6), b0 = nl & 63;
                    const f32x4 ar = acc[0][bj][m][n], ai = acc[1][bj][m][n]; float xr[4], xi[4];
#pragma unroll
                    for (int j = 0; j < 4; ++j) { const float ph = (float)((b0 + j) * c) * (6.283185307179586f / 8192.f); const float cs = __cosf(ph), sn = __sinf(ph);
                        xr[j] = ar[j] * cs + ai[j] * sn; xi[j] = ai[j] * cs - ar[j] * sn; }
                    bf16_t* q = B2t + ((size_t)c * 1024 + colg) * 128 + b0;
                    u32x2 w; w.x = cvt_pk_bf16(xr[0], xr[1]); w.y = cvt_pk_bf16(xr[2], xr[3]); *(u32x2*)q = w;
                    w.x = cvt_pk_bf16(xi[0], xi[1]); w.y = cvt_pk_bf16(xi[2], xi[3]); *(u32x2*)(q + 64) = w; } }
    }
};
struct EpiDft2 {
    static constexpr bool PERM = true;
    bf16_t* PQ;
    DI void operator()(const f32x4 (&acc)[2][2][4][2], const Unit& u, int wr, int wc, int fr_, int fq_) const {
        int fr = fr_, fq = fq_; asm volatile("" : "+v"(fr), "+v"(fq));
        const int c = u.pn >> 2;
#pragma unroll
        for (int m = 0; m < 4; ++m) { const int d = m * 16 + fr;
#pragma unroll
            for (int bj = 0; bj < 2; ++bj) { const int colg = (u.pn & 3) * BM + bj * HALF + wc * 32 + 8 * fq; const int batch = colg >> 9, ch = colg & 511;
                const f32x4 v0 = acc[0][bj][m][0], v1 = acc[0][bj][m][1];
                u32x4 w; w.x = cvt_pk_bf16(v0[0], v0[1]); w.y = cvt_pk_bf16(v0[2], v0[3]); w.z = cvt_pk_bf16(v1[0], v1[1]); w.w = cvt_pk_bf16(v1[2], v1[3]);
                *(u32x4*)(PQ + ((size_t)batch * TPB + CTXL + c + 128 * d) * 1024 + wr * 512 + ch) = w; } }
    }
};
struct EpiDftCtx {
    static constexpr bool PERM = false;
    bf16_t* PQ;
    DI void operator()(const f32x4 (&acc)[2][2][4][2], const Unit& u, int wr, int wc, int fr_, int fq_) const {
        int fr = fr_, fq = fq_; asm volatile("" : "+v"(fr), "+v"(fq));
        const int b = u.pn >> 1; const int colt = (u.pn & 1) * BM + wc * 32 + 4 * fq;
        bf16_t* base = PQ + (size_t)b * TPB * 1024 + (u.pm ? 512 : 0);
#pragma unroll
        for (int ai = 0; ai < 2; ++ai)
#pragma unroll
            for (int m = 0; m < 4; ++m) { const int k1 = ai * HALF + wr * 64 + m * 16 + fr;
#pragma unroll
                for (int bj = 0; bj < 2; ++bj)
#pragma unroll
                    for (int n = 0; n < 2; ++n) { const int c = colt + bj * HALF + n * 16; const f32x4 v = acc[ai][bj][m][n];
                        u32x2 w; w.x = cvt_pk_bf16(v[0], v[1]); w.y = cvt_pk_bf16(v[2], v[3]);
                        *(u32x2*)(base + (size_t)k1 * 1024 + c) = w; } }
    }
};
}

namespace att {
constexpr int QP = 272, VP = 144;
constexpr int Q_OFF = 0, K_OFF = 256 * QP  , K_BYTES = 64 * QP  , V_OFF = K_OFF + 2 * K_BYTES  , V_BYTES = 128 * VP  ;
static_assert(V_OFF + 3 * V_BYTES <= LDS_BYTES - 16, "attention LDS (3 V buffers)");
#define MFMA32(a, b, c) __builtin_amdgcn_mfma_f32_32x32x16_bf16((a), (b), (c), 0, 0, 0)
DI bf16x8 pack8(float a0, float a1, float a2, float a3, float a4, float a5, float a6, float a7) {
    u32x4 p;
    asm volatile("v_cvt_pk_bf16_f32 %0, %4, %5\n\tv_cvt_pk_bf16_f32 %1, %6, %7\n\tv_cvt_pk_bf16_f32 %2, %8, %9\n\tv_cvt_pk_bf16_f32 %3, %10, %11\n\ts_nop 1"
                 : "=&v"(p[0]), "=&v"(p[1]), "=&v"(p[2]), "=&v"(p[3])
                 : "v"(a0), "v"(a1), "v"(a2), "v"(a3), "v"(a4), "v"(a5), "v"(a6), "v"(a7));
    return __builtin_bit_cast(bf16x8, p);
}
template <bool SHIFT> DI void attn_unit(LAS unsigned char* lds, const bf16_t* Qb, const bf16_t* Kb, const bf16_t* Vt, bf16_t* concat,
                  int b, int h, int qt, float shift2, float lam, int lam_init_bits, const float* subln_g) {
    const int tid = TID(), wid = __builtin_amdgcn_readfirstlane(tid >> 6), lane = tid & 63, r = lane & 31, hh = lane >> 5;
    const size_t rowbase = (size_t)b * TPB;
    const int q0 = qt * 256;
    const int nkt = (qt == 0) ? 4 : NCH;
    const bf16_t* kg = Kb + rowbase * 1024 + h * 128;
    const bf16_t* vg = Vt + ((size_t)(b * 8 + h) * 128) * TPB;
    const int krow0 = tid >> 4, kc = tid & 15;
    const int vrow0 = tid >> 3, vc = tid & 7;
#pragma unroll
    for (int i = 0; i < 8; ++i) { const int id = i * 512 + tid, row = id >> 4, c = id & 15;
        const u32x4 v = *(const u32x4*)(Qb + (rowbase + q0 + row) * 1024 + h * 128 + c * 8);
        *(LAS u32x4*)(lds + Q_OFF + row * QP + c * 16) = v; }
    u32x4 sg0, sg1;
    sg0 = *(const u32x4*)(kg + (size_t)(krow0) * 1024 + kc * 8); sg1 = *(const u32x4*)(kg + (size_t)(krow0 + 32) * 1024 + kc * 8);
    *(LAS u32x4*)(lds + K_OFF + krow0 * QP + kc * 16) = sg0; *(LAS u32x4*)(lds + K_OFF + (krow0 + 32) * QP + kc * 16) = sg1;
    sg0 = *(const u32x4*)(vg + (size_t)(vrow0) * TPB + vc * 8); sg1 = *(const u32x4*)(vg + (size_t)(vrow0 + 64) * TPB + vc * 8);
    *(LAS u32x4*)(lds + V_OFF + vrow0 * VP + vc * 16) = sg0; *(LAS u32x4*)(lds + V_OFF + (vrow0 + 64) * VP + vc * 16) = sg1;
    if (nkt > 1) { sg0 = *(const u32x4*)(kg + (size_t)(64 + krow0) * 1024 + kc * 8); sg1 = *(const u32x4*)(kg + (size_t)(64 + krow0 + 32) * 1024 + kc * 8); }
    __syncthreads();
    f32x16 OT[2][4];
#pragma unroll
    for (int m = 0; m < 2; ++m)
#pragma unroll
        for (int t = 0; t < 4; ++t)
#pragma unroll
            for (int i = 0; i < 16; ++i) OT[m][t][i] = 0.f;
    float lsum[2] = {0.f, 0.f};
    const LAS unsigned char* qrow = lds + Q_OFF + (32 * wid + r) * QP + hh * 16;
#define SB0() __builtin_amdgcn_sched_barrier(0)
#define QKEXP(P_, half_) do { _Pragma("unroll") for (int m = 0; m < 2; ++m) { \
        f32x16 st; _Pragma("unroll") for (int i = 0; i < 16; ++i) st[i] = 0.f; \
        bf16x8 fq, fk; \
        fq = *(const LAS bf16x8*)(qrow + m * 128); fk = *(const LAS bf16x8*)(kb + (half_) * 32 * QP + m * 128); \
        _Pragma("unroll") for (int s = 0; s < 4; ++s) { \
            SB0(); st = MFMA32(fk, fq, st); SB0(); \
            if (s < 3) { fq = *(const LAS bf16x8*)(qrow + m * 128 + (s + 1) * 32); fk = *(const LAS bf16x8*)(kb + (half_) * 32 * QP + m * 128 + (s + 1) * 32); } } \
        float ls = 0.f; \
        _Pragma("unroll") for (int g_ = 0; g_ < 2; ++g_) { float e_[8]; _Pragma("unroll") for (int i_ = 0; i_ < 8; ++i_) { e_[i_] = __builtin_amdgcn_exp2f(SHIFT ? st[8 * g_ + i_] - shift2 : st[8 * g_ + i_]); ls += e_[i_]; } \
            P_[m][g_] = pack8(e_[0], e_[1], e_[2], e_[3], e_[4], e_[5], e_[6], e_[7]); } \
        lsum[m] += ls; } } while (0)
#define PVH(P_, vptr_) do { bf16x8 fv; fv = *(const LAS bf16x8*)(vptr_); \
        _Pragma("unroll") for (int it = 0; it < 8; ++it) { const int mt = it & 3, sI = it >> 2; \
            SB0(); OT[0][mt] = MFMA32(fv, P_[0][sI], OT[0][mt]); OT[1][mt] = MFMA32(fv, P_[1][sI], OT[1][mt]); SB0(); \
            if (it < 7) { const int mt2 = (it + 1) & 3, s2 = (it + 1) >> 2; fv = *(const LAS bf16x8*)((vptr_) + mt2 * 32 * VP + s2 * 32); } } } while (0)
    const bool lag = wid >= 4;
    bf16x8 Pc[2][2];
#pragma unroll
    for (int m = 0; m < 2; ++m)
#pragma unroll
        for (int g = 0; g < 2; ++g) { u32x4 z = {0u, 0u, 0u, 0u}; Pc[m][g] = __builtin_bit_cast(bf16x8, z); }
    const LAS unsigned char* vold = lds + V_OFF + r * VP + hh * 16;
    int vcur = 0;
    for (int kt = 0; kt < nkt; ++kt) {
        const int cur = kt & 1, nx = cur ^ 1;
        const int vnx = vcur == 2 ? 0 : vcur + 1;
        const bool pf = (kt + 1 < nkt);
        const size_t ko = (size_t)(kt + 1) * 64;
        if (pf) { *(LAS u32x4*)(lds + K_OFF + nx * K_BYTES + krow0 * QP + kc * 16) = sg0; *(LAS u32x4*)(lds + K_OFF + nx * K_BYTES + (krow0 + 32) * QP + kc * 16) = sg1;
            sg0 = *(const u32x4*)(vg + (size_t)(vrow0) * TPB + ko + vc * 8); sg1 = *(const u32x4*)(vg + (size_t)(vrow0 + 64) * TPB + ko + vc * 8); }
        const LAS unsigned char* kb = lds + K_OFF + cur * K_BYTES + r * QP + hh * 16;
        const LAS unsigned char* vb = lds + V_OFF + vcur * V_BYTES + r * VP + hh * 16;
#pragma unroll
        for (int half = 0; half < 2; ++half) {
            if (lag) PVH(Pc, vold);
            QKEXP(Pc, half);
            if (half == 0 && pf) { *(LAS u32x4*)(lds + V_OFF + vnx * V_BYTES + vrow0 * VP + vc * 16) = sg0; *(LAS u32x4*)(lds + V_OFF + vnx * V_BYTES + (vrow0 + 64) * VP + vc * 16) = sg1;
                if (kt + 2 < nkt) { sg0 = *(const u32x4*)(kg + (ko + 64 + krow0) * 1024 + kc * 8); sg1 = *(const u32x4*)(kg + (ko + 64 + krow0 + 32) * 1024 + kc * 8); } }
            vold = vb + half * 64;
            SB0();
            if (!lag) PVH(Pc, vold);
        }
        __syncthreads();
        vcur = vnx;
    }
    if (lag) PVH(Pc, vold);
#undef QKEXP
#undef PVH
#undef SB0
    const float l0 = lsum[0] + __shfl_xor(lsum[0], 32), l1 = lsum[1] + __shfl_xor(lsum[1], 32);
    const float i0 = 1.f / l0, c1 = lam / l1;
    float ss = 0.f;
#pragma unroll
    for (int mt = 0; mt < 4; ++mt)
#pragma unroll
        for (int i = 0; i < 16; ++i) { const float o = OT[0][mt][i] * i0 - OT[1][mt][i] * c1; OT[0][mt][i] = o; ss += o * o; }
    ss += __shfl_xor(ss, 32);
    int lib = lam_init_bits; asm volatile("" : "+s"(lib));
    const float rs = rsqrtf(ss * (1.f / 128.f) + EPS) * (1.f - __builtin_bit_cast(float, lib));
    LAS unsigned char* stg = lds + Q_OFF + (32 * wid) * QP;
#pragma unroll
    for (int mt = 0; mt < 4; ++mt)
#pragma unroll
        for (int g = 0; g < 4; ++g) { const int dv0 = 32 * mt + 8 * g + 4 * hh; const f32x4 gv = *(const f32x4*)(subln_g + dv0);
            u32x2 w; w.x = pk2(OT[0][mt][4 * g] * rs * gv[0], OT[0][mt][4 * g + 1] * rs * gv[1]); w.y = pk2(OT[0][mt][4 * g + 2] * rs * gv[2], OT[0][mt][4 * g + 3] * rs * gv[3]);
            *(LAS u32x2*)(stg + r * QP + dv0 * 2) = w; }
    LDS_WAIT();
#pragma unroll
    for (int i = 0; i < 8; ++i) { const int id = i * 64 + lane, row = id >> 4, c = id & 15;
        const u32x4 v = *(const LAS u32x4*)(stg + row * QP + c * 16);
        *(u32x4*)(concat + (rowbase + q0 + 32 * wid + row) * DM + h * 128 + c * 8) = v; }
    __syncthreads();
}
}

struct Params { const float* in[20]; float* out; unsigned char* ws; int ph_lo, ph_hi, coop, pad; };
enum { I_X = 0, I_C, I_CTX, I_CCTX, I_WMOD, I_BMOD, I_N1G, I_N2G, I_WIN, I_QG, I_KG, I_LAM, I_SUBLN, I_WUP, I_BUP, I_GLAG, I_WF, I_WOUT, I_WFF1, I_WFF2 };

typedef const __attribute__((address_space(4))) Params* KParamsPtr;
DI KParamsPtr KP() { KParamsPtr q = (KParamsPtr)__builtin_amdgcn_kernarg_segment_ptr(); asm volatile("" : "+s"(q)); return q; }
#define PRM (*KP())

DI void tr_item(const float* W, int ldw, int k0, int srcc0, bf16_t* WT, int K, int dstr0, LAS float* scr, int lane) {
#pragma unroll
    for (int i = 0; i < 32; ++i) { const int kk = 2 * i + (lane >> 5); scr[kk * 33 + (lane & 31)] = srcc0 >= 0 ? W[(size_t)(k0 + kk) * ldw + srcc0 + (lane & 31)] : 0.f; }
    LDS_WAIT();
    const int c = lane & 7;
#pragma unroll
    for (int j = 0; j < 4; ++j) { const int n = (lane >> 3) + 8 * j; const LAS float* s = scr + (8 * c) * 33 + n;
        u32x4 o; o.x = pk2(s[0 * 33], s[1 * 33]); o.y = pk2(s[2 * 33], s[3 * 33]); o.z = pk2(s[4 * 33], s[5 * 33]); o.w = pk2(s[6 * 33], s[7 * 33]);
        *(u32x4*)(WT + (size_t)(dstr0 + n) * K + k0 + 8 * c) = o; }
    LDS_WAIT();
}
DI int win_src_col(int n0) {
    if (n0 < 3072 + 1536) return n0;
    if (n0 < 3072 + 2048) return 4640 + (n0 - 4608);
    if (n0 < 3072 + 2080) return 4608 + (n0 - 5120);
    return -1;
}

DI void phase_prep(LAS unsigned char* lds, int l) {
    const int tid = TID(), wid = tid >> 6, lane = tid & 63, G = GDIM(), bx = BID();
    unsigned char* ws = LP(PRM.ws);
    LAS float* tab = (LAS float*)lds;
    for (int m = tid; m < 8192; m += 512) tab[m] = __cosf((float)m * (6.283185307179586f / 8192.f));
    __syncthreads();
    {
        bf16_t* A1 = (bf16_t*)(ws + WS_A1); bf16_t* A2 = (bf16_t*)(ws + WS_A2);
        for (int idx = bx * 512 + tid; idx < 2 * 256 * 128; idx += G * 512) {
            const int which = idx >> 15, m = (idx >> 7) & 255, k = idx & 127; float v;
            if (which == 0) { const int c = m & 127; const float cs = tab[(unsigned)(k * c * 64) & 8191u], sn = tab[((unsigned)(k * c * 64) + 8192u - 2048u) & 8191u]; v = (m < 128 ? cs : -sn) * (1.f / 1024.f); A1[m * 128 + k] = (bf16_t)f2bf(v); }
            else { const int d = m & 63, bb = k & 63; const float cs = tab[(unsigned)(bb * d * 128) & 8191u], sn = tab[((unsigned)(bb * d * 128) + 8192u - 2048u) & 8191u];
                if (m < 64) v = k < 64 ? cs : sn; else if (m < 128) v = k < 64 ? sn : -cs; else v = 0.f;
                A2[m * 128 + k] = (bf16_t)f2bf(v); } }
        if (l == 0) {
            bf16_t* Tc = (bf16_t*)(ws + WS_TCTX);
            for (int id = bx * 512 + tid; id < 512 * 32; id += G * 512) {
                const int rr = id >> 5, n0 = (id & 31) * 8; const bool sp = rr >= 256; const unsigned k1 = sp ? rr - 256 : rr; const unsigned sh = sp ? 8192u - 2048u : 0u;
                float v[8];
#pragma unroll
                for (int j = 0; j < 8; ++j) v[j] = tab[(k1 * (unsigned)(n0 + j) * 32u + sh) & 8191u] * 0.005524271728019903f;
                u32x4 o; o.x = pk2(v[0], v[1]); o.y = pk2(v[2], v[3]); o.z = pk2(v[4], v[5]); o.w = pk2(v[6], v[7]);
                *(u32x4*)(Tc + (size_t)id * 8) = o; } }
        const float* wf = PRM.in[I_WF] + (size_t)l * 512 * 512; bf16_t* Wcs = (bf16_t*)(ws + WS_WCS);
        for (int idx = bx * 512 + tid; idx < 512 * 1024; idx += G * 512) {
            const int j = idx & 511, kk = idx >> 9; const bool sp = kk >= 512; const int k2i = kk & 511, g = k2i >> 7, n2 = k2i & 127; const unsigned sh = sp ? 8192u - 2048u : 0u;
            float acc = 0.f;
            for (int k2 = 0; k2 < 128; ++k2) acc += tab[((unsigned)((k2 * n2) & 127) * 64u + sh) & 8191u] * wf[(size_t)(g * 128 + k2) * 512 + j];
            Wcs[(size_t)j * 1024 + kk] = (bf16_t)f2bf(sp ? -acc : acc); }
    }
    {
        LAS float* scr = (LAS float*)(lds + 32768 + wid * 8448);
        const int gw = bx * 8 + wid, NGW = G * 8;
        constexpr int I_IN = 32 * (NIN / 32), I_OUT = 32 * 64, I_F1 = 32 * 256, I_F2 = 128 * 64;
        const float* win = PRM.in[I_WIN] + (size_t)l * DM * DIN; const float* wout = PRM.in[I_WOUT] + (size_t)l * DM * DM;
        const float* wf1 = PRM.in[I_WFF1] + (size_t)l * DM * DFF; const float* wf2 = PRM.in[I_WFF2] + (size_t)l * DFF * DM;
        for (int it = gw; it < I_IN + I_OUT + I_F1 + I_F2; it += NGW) {
            int r = it;
            if (r < I_IN) { const int nb = r % (NIN / 32), kb = r / (NIN / 32); tr_item(win, DIN, kb * 64, win_src_col(nb * 32), (bf16_t*)(ws + WS_WIN), DM, nb * 32, scr, lane); continue; } r -= I_IN;
            if (r < I_OUT) { const int nb = r % 64, kb = r / 64; tr_item(wout, DM, kb * 64, nb * 32, (bf16_t*)(ws + WS_WOUT), DM, nb * 32, scr, lane); continue; } r -= I_OUT;
            if (r < I_F1) { const int nb = r % 256, kb = r / 256; tr_item(wf1, DFF, kb * 64, nb * 32, (bf16_t*)(ws + WS_WFF1), DM, nb * 32, scr, lane); continue; } r -= I_F1;
            { const int nb = r % 64, kb = r / 64; tr_item(wf2, DM, kb * 64, nb * 32, (bf16_t*)(ws + WS_WFF2), DFF, nb * 32, scr, lane); }
        }
    }
    __syncthreads();
    if (l == 0) {
        LAS float* sv = (LAS float*)lds;
        LAS float* red = (LAS float*)(lds + 24576);
        for (int i = tid; i < 3 * 2048; i += 512) { const int s = i >> 11, k = i & 2047; const float c = s < 2 ? PRM.in[I_C][s * 2048 + k] : PRM.in[I_CCTX][k]; sv[i] = c / (1.f + __expf(-c)); }
        __syncthreads();
        float* mod = (float*)(ws + WS_MOD);
        const int cl = tid & 15, ks = tid >> 4;
        for (int item = bx; item < 2 * 192; item += G) {
            const int l2 = item / 192, j0 = (item % 192) * 64;
            const float* wm = PRM.in[I_WMOD] + ((size_t)l2 * 2048 + ks * 64) * 12288 + j0 + cl * 4;
            f32x4 a0 = {0.f, 0.f, 0.f, 0.f}, a1 = a0, a2 = a0;
#pragma unroll 8
            for (int kk = 0; kk < 64; ++kk) { const f32x4 w = *(const f32x4*)(wm + (size_t)kk * 12288); const int k = ks * 64 + kk;
                a0 += w * sv[k]; a1 += w * sv[2048 + k]; a2 += w * sv[4096 + k]; }
#pragma unroll
            for (int i = 0; i < 4; ++i) { red[(ks * 3 + 0) * 64 + cl * 4 + i] = a0[i]; red[(ks * 3 + 1) * 64 + cl * 4 + i] = a1[i]; red[(ks * 3 + 2) * 64 + cl * 4 + i] = a2[i]; }
            __syncthreads();
            if (tid < 192) { const int s = tid >> 6, ci = tid & 63; float t = PRM.in[I_BMOD][(size_t)l2 * 12288 + j0 + ci];
                for (int k2 = 0; k2 < 32; ++k2) t += red[(k2 * 3 + s) * 64 + ci];
                mod[((size_t)l2 * 3 + s) * 12288 + j0 + ci] = t; }
            __syncthreads();
        }
    }
}

DI const float* hrow_in(int l, int b, int t) {
    if (l == 0) return t < CTXL ? PRM.in[I_CTX] + ((size_t)b * CTXL + t) * DM : PRM.in[I_X] + ((size_t)b * SEQ + (t - CTXL)) * DM;
    return t < CTXL ? (const float*)(LP(PRM.ws) + WS_XC) + ((size_t)b * CTXL + t) * DM : PRM.out + ((size_t)b * SEQ + (t - CTXL)) * DM;
}
DI void phase_norm(int l, int stage, bool skipctx, int fold, int gate_l, int gate_chunk, const void* latsrc, int lat_bf16) {
    const int tid = TID(), wid = tid >> 6, lane = tid & 63;
    const float* mod = (const float*)(LP(PRM.ws) + WS_MOD); bf16_t* A = (bf16_t*)(LP(PRM.ws) + WS_A);
    const float* gvec = PRM.in[stage == 0 ? I_N1G : I_N2G] + (size_t)l * DM;
    f32x4 ggv[8], shv[8]; int cur_s = -1;
    for (int row = BID() * 8 + wid; row < MROWS; row += GDIM() * 8) {
        const int b = row / TPB, t = row % TPB; const bool isctx = t < CTXL;
        if (skipctx && isctx) continue;
        const int ssel = isctx ? 2 : b;
        if (ssel != cur_s) { cur_s = ssel;
            const float* sh = mod + ((size_t)l * 3 + ssel) * 12288 + (size_t)(stage * 3) * DM; const float* sc = sh + DM;
#pragma unroll
            for (int j = 0; j < 8; ++j) { const int c = 4 * (64 * j + lane); ggv[j] = *(const f32x4*)(gvec + c) * (*(const f32x4*)(sc + c) + 1.f); shv[j] = *(const f32x4*)(sh + c); } }
        const float* src = hrow_in(stage == 0 ? l : 1, b, t);
        if (isctx && fold == 1) src = PRM.in[I_CTX] + ((size_t)b * CTXL + t) * DM;
        f32x4 v[8]; float ss = 0.f;
        if (!isctx && lat_bf16) { const bf16_t* sb_ = (const bf16_t*)latsrc + ((size_t)b * SEQ + (t - CTXL)) * DM;
#pragma unroll
            for (int j = 0; j < 8; ++j) { const u32x2 w = *((const u32x2*)sb_ + 64 * j + lane); v[j] = (f32x4){bf2f(w.x & 0xffff), bf2f(w.x >> 16), bf2f(w.y & 0xffff), bf2f(w.y >> 16)}; } }
        else { if (!isctx) src = (const float*)latsrc + ((size_t)b * SEQ + (t - CTXL)) * DM;
#pragma unroll
            for (int j = 0; j < 8; ++j) v[j] = *((const f32x4*)src + 64 * j + lane); }
        if (isctx && fold) {
            const float* part = (const float*)(LP(PRM.ws) + WS_PART) + ((size_t)b * CTXL + t) * DM; const float* gt = mod + ((size_t)gate_l * 3 + 2) * 12288 + (size_t)gate_chunk * DM;
            float* xc = (float*)(LP(PRM.ws) + WS_XC) + ((size_t)b * CTXL + t) * DM;
#pragma unroll
            for (int j = 0; j < 8; ++j) { f32x4 a = *((const f32x4*)part + 64 * j + lane);
#pragma unroll
                for (int k = 1; k < NSPLIT; ++k) a += *((const f32x4*)(part + (size_t)k * 512 * DM) + 64 * j + lane);
                v[j] += a * *((const f32x4*)gt + 64 * j + lane); *((f32x4*)xc + 64 * j + lane) = v[j]; }
        }
#pragma unroll
        for (int j = 0; j < 8; ++j) ss += (v[j][0] * v[j][0] + v[j][1] * v[j][1]) + (v[j][2] * v[j][2] + v[j][3] * v[j][3]);
        const float rs = rsqrtf(wave_sum(ss) * (1.f / DM) + EPS);
#pragma unroll
        for (int j = 0; j < 8; ++j) { const int c = 4 * (64 * j + lane);
            const f32x4 y = v[j] * rs * ggv[j] + shv[j];
            u32x2 w; w.x = pk2(y[0], y[1]); w.y = pk2(y[2], y[3]); *(u32x2*)(A + (size_t)row * DM + c) = w; }
    }
}

DI void tr_unit(LAS unsigned char* lds, const bf16_t* src, int ld, bf16_t* dst, size_t dpitch, bool perm) {
    const int tid = TID();
#pragma unroll
    for (int i = 0; i < 2; ++i) { const int id = i * 512 + tid, row = id >> 4, c = id & 15;
        *(LAS u32x4*)(lds + row * 272 + c * 16) = *(const u32x4*)(src + (size_t)row * ld + c * 8); }
    __syncthreads();
#pragma unroll
    for (int i = 0; i < 2; ++i) { const int id = i * 512 + tid, j = id >> 3, c = id & 7; unsigned e[8];
#pragma unroll
        for (int q = 0; q < 8; ++q) { const int key = perm ? (16 * (c >> 1) + 8 * (q >> 2) + 4 * (c & 1) + (q & 3)) : (8 * c + q); e[q] = *(const LAS unsigned short*)(lds + key * 272 + j * 2); }
        u32x4 o; o.x = e[0] | (e[1] << 16); o.y = e[2] | (e[3] << 16); o.z = e[4] | (e[5] << 16); o.w = e[6] | (e[7] << 16);
        *(u32x4*)(dst + (size_t)j * dpitch + c * 8) = o; }
    __syncthreads();
}

DI void gla_load(LAS unsigned char* lds, int l, int b, int h, int c, int off_q  , int off_k, int off_v, int off_pa, int off_wup, int off_bup) {
    const int tid = TID();
    const bf16_t* P2 = (const bf16_t*)(LP(PRM.ws) + WS_P2) + ((size_t)b * TPB + (size_t)c * 64) * P2W;
    { const int row = tid >> 3, c8 = tid & 7;
      const u32x4 kv = *(const u32x4*)(P2 + (size_t)row * P2W + 256 + h * 64 + c8 * 8); LAS float* kd = (LAS float*)(lds + off_k) + row * 64 + c8 * 8;
      kd[0] = bf2f(kv.x & 0xffff); kd[1] = bf2f(kv.x >> 16); kd[2] = bf2f(kv.y & 0xffff); kd[3] = bf2f(kv.y >> 16); kd[4] = bf2f(kv.z & 0xffff); kd[5] = bf2f(kv.z >> 16); kd[6] = bf2f(kv.w & 0xffff); kd[7] = bf2f(kv.w >> 16);
      if (off_q >= 0) { const u32x4 qv = *(const u32x4*)(P2 + (size_t)row * P2W + h * 64 + c8 * 8); LAS float* qd = (LAS float*)(lds + off_q) + row * 64 + c8 * 8;
        qd[0] = bf2f(qv.x & 0xffff); qd[1] = bf2f(qv.x >> 16); qd[2] = bf2f(qv.y & 0xffff); qd[3] = bf2f(qv.y >> 16); qd[4] = bf2f(qv.z & 0xffff); qd[5] = bf2f(qv.z >> 16); qd[6] = bf2f(qv.w & 0xffff); qd[7] = bf2f(qv.w >> 16); } }
#pragma unroll
    for (int i = 0; i < 2; ++i) { const int id = i * 512 + tid, row = id >> 4, c8 = id & 15;
        const u32x4 vv = *(const u32x4*)(P2 + (size_t)row * P2W + 512 + h * 128 + c8 * 8); LAS float* vd = (LAS float*)(lds + off_v) + row * 128 + c8 * 8;
        vd[0] = bf2f(vv.x & 0xffff); vd[1] = bf2f(vv.x >> 16); vd[2] = bf2f(vv.y & 0xffff); vd[3] = bf2f(vv.y >> 16); vd[4] = bf2f(vv.z & 0xffff); vd[5] = bf2f(vv.z >> 16); vd[6] = bf2f(vv.w & 0xffff); vd[7] = bf2f(vv.w >> 16); }
    if (tid < 256) { const int row = tid >> 2, c8 = tid & 3;
        const u32x4 pv = *(const u32x4*)(P2 + (size_t)row * P2W + 2048 + c8 * 8); LAS float* pd = (LAS float*)(lds + off_pa) + row * 32 + c8 * 8;
        pd[0] = bf2f(pv.x & 0xffff); pd[1] = bf2f(pv.x >> 16); pd[2] = bf2f(pv.y & 0xffff); pd[3] = bf2f(pv.y >> 16); pd[4] = bf2f(pv.z & 0xffff); pd[5] = bf2f(pv.z >> 16); pd[6] = bf2f(pv.w & 0xffff); pd[7] = bf2f(pv.w >> 16); }
#pragma unroll
    for (int i = 0; i < 4; ++i) { const int idx = tid * 4 + i, d = idx >> 10, rr = (idx >> 6) & 15, dk = idx & 63;
        ((LAS float*)(lds + off_wup))[idx] = PRM.in[I_WUP][((size_t)(l * 2 + d) * 16 + rr) * 256 + h * 64 + dk]; }
    if (tid < 128) { const int d = tid >> 6, dk = tid & 63; ((LAS float*)(lds + off_bup))[tid] = PRM.in[I_BUP][(size_t)(l * 2 + d) * 256 + h * 64 + dk]; }
}
DI float gla_cumsum(const LAS float* paf, const LAS float* wup, const LAS float* bup, int d, int dk, LAS float* out) {
    float w[16];
#pragma unroll
    for (int rr = 0; rr < 16; ++rr) w[rr] = wup[(d * 16 + rr) * 64 + dk];
    const float bb = bup[d * 64 + dk];
    float run = 0.f;
    for (int s = 0; s < 64; ++s) { const int t = d ? 63 - s : s; float z = bb;
#pragma unroll
        for (int rr = 0; rr < 16; ++rr) z += paf[t * 32 + d * 16 + rr] * w[rr];
        run += logsig(z) * (1.f / 16.f); out[t * 64 + dk] = run; }
    return run;
}
DI void gla_g1_unit(LAS unsigned char* lds, int l, int b, int h, int c) {
    constexpr int OK = 0, OV = 16384, OPA = 49152, OWUP = 57344, OBUP = 65536, OE = 66560;
    const int tid = TID();
    gla_load(lds, l, b, h, c, -1, OK, OV, OPA, OWUP, OBUP);
    __syncthreads();
    const LAS float* kf = (const LAS float*)(lds + OK); const LAS float* vf = (const LAS float*)(lds + OV);
    LAS float* E = (LAS float*)(lds + OE);
    bf16_t* KV = (bf16_t*)(LP(PRM.ws) + WS_KV); float* DEC = (float*)(LP(PRM.ws) + WS_DEC);
    {
        const LAS float* paf = (const LAS float*)(lds + OPA); const LAS float* wup = (const LAS float*)(lds + OWUP); const LAS float* bup = (const LAS float*)(lds + OBUP);
        LAS float* bl_s = (LAS float*)(lds + OE + 32768);
        const int dk = tid & 63;
#pragma unroll
        for (int d = 0; d < 2; ++d) { float w[16];
#pragma unroll
            for (int rr = 0; rr < 16; ++rr) w[rr] = wup[(d * 16 + rr) * 64 + dk];
            const float bb = bup[d * 64 + dk];
            for (int t = tid >> 6; t < 64; t += 8) { float z = bb;
#pragma unroll
                for (int rr = 0; rr < 16; ++rr) z += paf[t * 32 + d * 16 + rr] * w[rr];
                E[d * 4096 + t * 64 + dk] = logsig(z) * (1.f / 16.f); } }
        __syncthreads();
        if (tid < 128) { const int d = tid >> 6; float run = 0.f;
            for (int s2 = 0; s2 < 64; ++s2) { const int t = d ? 63 - s2 : s2; run += E[d * 4096 + t * 64 + dk]; E[d * 4096 + t * 64 + dk] = run; }
            bl_s[d * 64 + dk] = run;
            DEC[((size_t)((b * 2 + d) * 4 + h) * NCH + c) * 64 + dk] = __expf(run); }
        __syncthreads();
#pragma unroll
        for (int i = 0; i < 16; ++i) { const int idx = i * 512 + tid, d = idx >> 12, td = idx & 4095; E[idx] = __expf(bl_s[d * 64 + (td & 63)] - E[idx]) * kf[td]; }
    }
    __syncthreads();
    { const int d = tid >> 8, tt = tid & 255, dvq = tt & 31, dkq = tt >> 5; const LAS float* Ed = E + d * 4096;
      f32x4 acc[8];
#pragma unroll
      for (int i = 0; i < 8; ++i) acc[i] = (f32x4){0.f, 0.f, 0.f, 0.f};
      for (int t = 0; t < 64; ++t) { const f32x4 vv = *(const LAS f32x4*)(vf + t * 128 + 4 * dvq);
#pragma unroll
          for (int i = 0; i < 8; ++i) acc[i] += vv * Ed[t * 64 + dkq * 8 + i]; }
      bf16_t* dst = KV + ((size_t)((b * 2 + d) * 4 + h) * NCH + c) * 8192;
#pragma unroll
      for (int i = 0; i < 8; ++i) { u32x2 w; w.x = pk2(acc[i][0], acc[i][1]); w.y = pk2(acc[i][2], acc[i][3]); *(u32x2*)(dst + (dkq * 8 + i) * 128 + 4 * dvq) = w; } }
    __syncthreads();
}
DI void gla_scan() {
    const int tid = TID(); unsigned* KV = (unsigned*)(LP(PRM.ws) + WS_KV); const float* DEC = (const float*)(LP(PRM.ws) + WS_DEC);
    for (int item = BID(); item < 128; item += GDIM()) {
        const int seq = item >> 3, slab = item & 7, d = (seq >> 2) & 1, e2 = slab * 512 + tid  , dk = e2 >> 6;
        float S0 = 0.f, S1 = 0.f;
        for (int s0 = 0; s0 < NCH; s0 += 33) { unsigned kvv[33]; float dc[33];
#pragma unroll
            for (int j = 0; j < 33; ++j) { const int st = s0 + j, c = d ? (st < 4 ? 3 - st : 135 - st) : st; kvv[j] = KV[((size_t)seq * NCH + c) * 4096 + e2]; dc[j] = DEC[((size_t)seq * NCH + c) * 64 + dk]; }
#pragma unroll
            for (int j = 0; j < 33; ++j) { const int st = s0 + j, c = d ? (st < 4 ? 3 - st : 135 - st) : st; KV[((size_t)seq * NCH + c) * 4096 + e2] = pk2(S0, S1);
                S0 = dc[j] * S0 + bf2f(kvv[j] & 0xffff); S1 = dc[j] * S1 + bf2f(kvv[j] >> 16); } }
    }
}
DI void gla_g3_unit(LAS unsigned char* lds, int l, int b, int h, int c) {
    constexpr int OQ = 0, OK = 16384, OPA = 32768, OWUP = 40960, OBUP = 49152, OG = 50176, OVT = 82944, OQE = 101376, OKE = 110592, OST = 119808, OOT = 0, PB = 144;
    const int tid = TID(), wid = __builtin_amdgcn_readfirstlane(tid >> 6), lane = tid & 63, r = lane & 31, hh = lane >> 5;
    const bf16_t* P2 = (const bf16_t*)(LP(PRM.ws) + WS_P2) + ((size_t)b * TPB + (size_t)c * 64) * P2W;
    {
        const int row = tid >> 3, c8 = tid & 7;
        const u32x4 kv = *(const u32x4*)(P2 + (size_t)row * P2W + 256 + h * 64 + c8 * 8); LAS float* kd = (LAS float*)(lds + OK) + row * 64 + c8 * 8;
        kd[0] = bf2f(kv.x & 0xffff); kd[1] = bf2f(kv.x >> 16); kd[2] = bf2f(kv.y & 0xffff); kd[3] = bf2f(kv.y >> 16); kd[4] = bf2f(kv.z & 0xffff); kd[5] = bf2f(kv.z >> 16); kd[6] = bf2f(kv.w & 0xffff); kd[7] = bf2f(kv.w >> 16);
        const u32x4 qv = *(const u32x4*)(P2 + (size_t)row * P2W + h * 64 + c8 * 8); LAS float* qd = (LAS float*)(lds + OQ) + row * 64 + c8 * 8;
        qd[0] = bf2f(qv.x & 0xffff); qd[1] = bf2f(qv.x >> 16); qd[2] = bf2f(qv.y & 0xffff); qd[3] = bf2f(qv.y >> 16); qd[4] = bf2f(qv.z & 0xffff); qd[5] = bf2f(qv.z >> 16); qd[6] = bf2f(qv.w & 0xffff); qd[7] = bf2f(qv.w >> 16);
#pragma unroll
        for (int i = 0; i < 2; ++i) { const int id = i * 512 + tid, m = id >> 4, cc = id & 15;
            const u32x4 vv = *(const u32x4*)(P2 + (size_t)m * P2W + 512 + h * 128 + cc * 8);
            const int m16 = m & 15, pos = (m & ~15) + 8 * ((m16 >> 2) & 1) + ((m16 >> 3) << 2) + (m16 & 3);
            LAS unsigned short* vt = (LAS unsigned short*)(lds + OVT + (cc * 8) * PB + pos * 2);
            vt[0 * (PB / 2)] = vv.x & 0xffff; vt[1 * (PB / 2)] = vv.x >> 16; vt[2 * (PB / 2)] = vv.y & 0xffff; vt[3 * (PB / 2)] = vv.y >> 16;
            vt[4 * (PB / 2)] = vv.z & 0xffff; vt[5 * (PB / 2)] = vv.z >> 16; vt[6 * (PB / 2)] = vv.w & 0xffff; vt[7 * (PB / 2)] = vv.w >> 16; }
        if (tid < 256) { const int prow = tid >> 2, p8 = tid & 3;
            const u32x4 pv = *(const u32x4*)(P2 + (size_t)prow * P2W + 2048 + p8 * 8); LAS float* pd = (LAS float*)(lds + OPA) + prow * 32 + p8 * 8;
            pd[0] = bf2f(pv.x & 0xffff); pd[1] = bf2f(pv.x >> 16); pd[2] = bf2f(pv.y & 0xffff); pd[3] = bf2f(pv.y >> 16); pd[4] = bf2f(pv.z & 0xffff); pd[5] = bf2f(pv.z >> 16); pd[6] = bf2f(pv.w & 0xffff); pd[7] = bf2f(pv.w >> 16); }
#pragma unroll
        for (int i = 0; i < 4; ++i) { const int idx = tid * 4 + i, d = idx >> 10, rr = (idx >> 6) & 15, dk = idx & 63;
            ((LAS float*)(lds + OWUP))[idx] = PRM.in[I_WUP][((size_t)(l * 2 + d) * 16 + rr) * 256 + h * 64 + dk]; }
        if (tid < 128) { const int d = tid >> 6, dk = tid & 63; ((LAS float*)(lds + OBUP))[tid] = PRM.in[I_BUP][(size_t)(l * 2 + d) * 256 + h * 64 + dk]; }
    }
    __syncthreads();
    const LAS float* qf = (const LAS float*)(lds + OQ); const LAS float* kf = (const LAS float*)(lds + OK);
    const LAS float* paf = (const LAS float*)(lds + OPA); const LAS float* wup = (const LAS float*)(lds + OWUP); const LAS float* bup = (const LAS float*)(lds + OBUP);
    LAS float* gl = (LAS float*)(lds + OG);
    {
        const int dk = tid & 63;
#pragma unroll
        for (int d = 0; d < 2; ++d) { float w[16];
#pragma unroll
            for (int rr = 0; rr < 16; ++rr) w[rr] = wup[(d * 16 + rr) * 64 + dk];
            const float bb = bup[d * 64 + dk];
            for (int t = tid >> 6; t < 64; t += 8) { float z = bb;
#pragma unroll
                for (int rr = 0; rr < 16; ++rr) z += paf[t * 32 + d * 16 + rr] * w[rr];
                gl[d * 4096 + t * 64 + dk] = logsig(z) * (1.f / 16.f); } }
    }
    __syncthreads();
    if (tid < 128) { const int d = tid >> 6, dk = tid & 63; float run = 0.f;
        for (int s = 0; s < 64; ++s) { const int t = d ? 63 - s : s; run += gl[d * 4096 + t * 64 + dk]; gl[d * 4096 + t * 64 + dk] = run; } }
    __syncthreads();
    const int mt = wid & 3, ntl = wid >> 2;
    f32x16 acc;
#pragma unroll
    for (int i = 0; i < 16; ++i) acc[i] = 0.f;
    const bf16_t* KV = (const bf16_t*)(LP(PRM.ws) + WS_KV);
    for (int d = 0; d < 2; ++d) {
        {
#pragma unroll
            for (int i = 0; i < 4; ++i) { const int idx2 = (i * 512 + tid) * 2, t = idx2 >> 6, dk = idx2 & 63;
                const float b0 = gl[d * 4096 + idx2], b1 = gl[d * 4096 + idx2 + 1];
                *(LAS unsigned*)(lds + OQE + t * PB + dk * 2) = pk2(qf[idx2] * __expf(b0) * 0.125f, qf[idx2 + 1] * __expf(b1) * 0.125f);
                *(LAS unsigned*)(lds + OKE + t * PB + dk * 2) = pk2(kf[idx2] * __expf(-b0), kf[idx2 + 1] * __expf(-b1)); }
            const bf16_t* Sg = KV + ((size_t)((b * 2 + d) * 4 + h) * NCH + c) * 8192;
#pragma unroll
            for (int i = 0; i < 2; ++i) { const int id = i * 512 + tid, dk = id >> 4, dv8 = (id & 15) * 8; const u32x4 sv = *(const u32x4*)(Sg + dk * 128 + dv8);
                LAS unsigned short* st = (LAS unsigned short*)(lds + OST + dv8 * PB + dk * 2);
                st[0] = sv.x & 0xffff; st[PB / 2] = sv.x >> 16; st[2 * (PB / 2)] = sv.y & 0xffff; st[3 * (PB / 2)] = sv.y >> 16;
                st[4 * (PB / 2)] = sv.z & 0xffff; st[5 * (PB / 2)] = sv.z >> 16; st[6 * (PB / 2)] = sv.w & 0xffff; st[7 * (PB / 2)] = sv.w >> 16; }
        }
        __syncthreads();
        {
            bf16x8 qfr[4];
#pragma unroll
            for (int s = 0; s < 4; ++s) qfr[s] = *(const LAS bf16x8*)(lds + OQE + (32 * ntl + r) * PB + s * 32 + hh * 16);
#pragma unroll
            for (int s = 0; s < 4; ++s) { const bf16x8 sf = *(const LAS bf16x8*)(lds + OST + (32 * mt + r) * PB + s * 32 + hh * 16); acc = MFMA32(sf, qfr[s], acc); }
#pragma unroll
            for (int j = 0; j < 2; ++j) {
                f32x16 at;
#pragma unroll
                for (int i = 0; i < 16; ++i) at[i] = 0.f;
#pragma unroll
                for (int s = 0; s < 4; ++s) { const bf16x8 kfr = *(const LAS bf16x8*)(lds + OKE + (32 * j + r) * PB + s * 32 + hh * 16); at = MFMA32(kfr, qfr[s], at); }
                const int tcol = 32 * ntl + r;
#pragma unroll
                for (int i = 0; i < 16; ++i) { const int m = 32 * j + (i & 3) + 8 * (i >> 2) + 4 * hh; const bool keep = d ? (m >= tcol) : (m <= tcol); at[i] = keep ? at[i] : 0.f; }
#pragma unroll
                for (int s = 0; s < 2; ++s) {
                    const bf16x8 pf = att::pack8(at[8 * s], at[8 * s + 1], at[8 * s + 2], at[8 * s + 3], at[8 * s + 4], at[8 * s + 5], at[8 * s + 6], at[8 * s + 7]);
                    const bf16x8 vfr = *(const LAS bf16x8*)(lds + OVT + (32 * mt + r) * PB + (2 * j + s) * 32 + hh * 16);
                    acc = MFMA32(vfr, pf, acc); }
            }
        }
        __syncthreads();
    }
    {
        LAS float* oT = (LAS float*)(lds + OOT);
        const int t = 32 * ntl + r;
#pragma unroll
        for (int i = 0; i < 16; ++i) { const int dv = 32 * mt + (i & 3) + 8 * (i >> 2) + 4 * hh; oT[t * 132 + dv] = acc[i]; }
    }
    __syncthreads();
    const int tq = tid >> 5, dvq = tid & 31;
    const f32x4 gg = *(const f32x4*)(PRM.in[I_GLAG] + (size_t)l * 128 + 4 * dvq);
    bf16_t* concat = (bf16_t*)(LP(PRM.ws) + WS_A);
#pragma unroll
    for (int i = 0; i < 4; ++i) { const f32x4 o = *(const LAS f32x4*)(lds + OOT + ((4 * tq + i) * 132 + 4 * dvq) * 4);
        float ss = (o[0] * o[0] + o[1] * o[1]) + (o[2] * o[2] + o[3] * o[3]);
#pragma unroll
        for (int s = 1; s < 32; s <<= 1) ss += __shfl_xor(ss, s);
        const float rs = rsqrtf(ss * (1.f / 128.f) + EPS);
        const size_t row = (size_t)c * 64 + 4 * tq + i;
        const u32x2 rv = *(const u32x2*)(P2 + row % 64 * P2W + 1024 + h * 128 + 4 * dvq);
        float r4[4] = {bf2f(rv.x & 0xffff), bf2f(rv.x >> 16), bf2f(rv.y & 0xffff), bf2f(rv.y >> 16)}; float y[4];
#pragma unroll
        for (int j = 0; j < 4; ++j) y[j] = o[j] * rs * gg[j] * (r4[j] / (1.f + __expf(-r4[j])));
        u32x2 w; w.x = pk2(y[0], y[1]); w.y = pk2(y[2], y[3]); *(u32x2*)(concat + ((size_t)b * TPB + row) * DM + 1024 + h * 128 + 4 * dvq) = w; }
    __syncthreads();
}

DI void phase_post(LAS unsigned char* lds, int l, bool do_qk) {
    const int tid = TID(), wid = tid >> 6, lane = tid & 63, G = GDIM(), bx = BID();
    unsigned char* ws = LP(PRM.ws);
    if (do_qk) {
        const int lp = lane & 31, d0 = 2 * lp, dd = d0 & 31, i0 = dd & 15; const bool axis = d0 >= 32; const float sgn = dd < 16 ? -1.f : 1.f;
        const float inv0 = exp2f(-(float)i0 * (13.287712379549449f / 16.f)), inv1 = exp2f(-(float)(i0 + 1) * (13.287712379549449f / 16.f));
        for (int row = bx * 8 + wid; row < MROWS; row += G * 8) {
            const int t = row % TPB; const bool isctx = t < CTXL; const int tl = t - CTXL;
            const float pos = (float)(axis ? (tl & 63) : (tl >> 6));
            float s0 = 0.f, c0 = 1.f, s1 = 0.f, c1 = 1.f;
            if (!isctx) { const float a0 = pos * inv0, a1 = pos * inv1; s0 = __sinf(a0); c0 = __cosf(a0); s1 = __sinf(a1); c1 = __cosf(a1); }
            for (int which = 0; which < 2; ++which) {
                bf16_t* base = (bf16_t*)(ws + (which ? WS_KB : WS_QB)) + (size_t)row * 1024;
                const float* gvec = PRM.in[which ? I_KG : I_QG] + (size_t)l * 64; const float g0 = gvec[d0], g1 = gvec[d0 + 1];
                unsigned wv[8];
#pragma unroll
                for (int it = 0; it < 8; ++it) wv[it] = *(const unsigned*)(base + it * 128 + lane * 2);
#pragma unroll
                for (int it = 0; it < 8; ++it) { const unsigned w = wv[it];
                    const float x0 = bf2f(w & 0xffff), x1 = bf2f(w >> 16); float ss = x0 * x0 + x1 * x1;
#pragma unroll
                    for (int s = 1; s < 32; s <<= 1) ss += __shfl_xor(ss, s);
                    const float rs = rsqrtf(ss * (1.f / 64.f) + EPS); float y0 = x0 * rs * g0, y1 = x1 * rs * g1;
                    const float p0 = __shfl_xor(y0, 8), p1 = __shfl_xor(y1, 8);
                    if (!isctx) { y0 = y0 * c0 + sgn * p0 * s0; y1 = y1 * c1 + sgn * p1 * s1; }
                    if (which == 0) { y0 *= QSCALE; y1 *= QSCALE; }
                    wv[it] = pk2(y0, y1); }
#pragma unroll
                for (int it = 0; it < 8; ++it) *(unsigned*)(base + it * 128 + lane * 2) = wv[it];
            }
        }
    }
    for (int u = bx; u < NB * NCH * 8; u += G) { const int h = u & 7, kt = (u >> 3) % NCH, b = u / (8 * NCH);
        tr_unit(lds, (const bf16_t*)(ws + WS_VB) + ((size_t)b * TPB + (size_t)kt * 64) * 1024 + h * 128, 1024,
                (bf16_t*)(ws + WS_VT) + ((size_t)(b * 8 + h) * 128) * TPB + (size_t)kt * 64, TPB, true); }
    for (int u = bx; u < NB * 4 * 4; u += G) { const int cgp = u & 3, kt = (u >> 2) & 3, b = u >> 4;
        const bf16_t* src = (const bf16_t*)(ws + WS_P2) + ((size_t)b * TPB + (size_t)kt * 64) * P2W + 1536 + cgp * 128;
        tr_unit(lds, src, P2W, (bf16_t*)(ws + WS_UTC) + ((size_t)(b * 512 + cgp * 128)) * 256 + kt * 64, 256, false); }
    for (int u = bx; u < NB * 64 * 4; u += G) { const int cgp = u & 3, bb = (u >> 2) & 63, b = u >> 8;
        const bf16_t* src = (const bf16_t*)(ws + WS_P2) + ((size_t)b * TPB + CTXL + bb) * P2W + 1536 + cgp * 128;
        bf16_t* dst = (bf16_t*)(ws + WS_UTL) + ((size_t)(b * 512 + cgp * 128) * 64 + bb) * 128;
#pragma unroll
        for (int i = 0; i < 4; ++i) { const int id = i * 512 + tid, row = id >> 4, c = id & 15;
            *(LAS u32x4*)(lds + row * 272 + c * 16) = *(const u32x4*)(src + (size_t)row * 64 * P2W + c * 8); }
        __syncthreads();
#pragma unroll
        for (int i = 0; i < 4; ++i) { const int id = i * 512 + tid, j = id >> 4, c = id & 15; unsigned e[8];
#pragma unroll
            for (int q = 0; q < 8; ++q) e[q] = *(const LAS unsigned short*)(lds + (8 * c + q) * 272 + j * 2);
            u32x4 o; o.x = e[0] | (e[1] << 16); o.y = e[2] | (e[3] << 16); o.z = e[4] | (e[5] << 16); o.w = e[6] | (e[7] << 16);
            *(u32x4*)(dst + (size_t)j * 8192 + c * 8) = o; }
        __syncthreads(); }
    for (int u = bx; u < NB * 4 * NCH; u += G) { const int c = u % NCH, h = (u / NCH) & 3, b = u / (4 * NCH); gla_g1_unit(lds, l, b, h, c); }
}

#define XB_TMO      128
#define XB_XCNT(j)  (256  + 64 * (j))
#define XB_XSUB(j)  (1280 + 64 * (j))
#define XB_XGEN(j)  (2304 + 64 * (j))
#define XB_TOP      3328
#define XB_TOPGEN   3392
#define XCD_BAR_WORDS 3456
#define XB_SPIN_CAP (1u << 18)
DI unsigned xb_ld(unsigned* p)              { return __hip_atomic_load(p, __ATOMIC_RELAXED, __HIP_MEMORY_SCOPE_AGENT); }
DI unsigned xb_add(unsigned* p, unsigned v) { return __hip_atomic_fetch_add(p, v, __ATOMIC_RELAXED, __HIP_MEMORY_SCOPE_AGENT); }
DI unsigned xb_xcc_id() { return (unsigned)__builtin_amdgcn_s_getreg((3 << 11) | 20) & 0xFu; }
#define XB_SPIN(cond, bar) do { unsigned _sp = 0; while (cond) { __builtin_amdgcn_s_sleep(1); \
    if ((++_sp & 255u) == 0u) { if (xb_ld(&(bar)[XB_TMO])) break; if (_sp > XB_SPIN_CAP) { atomicAdd(&(bar)[XB_TMO], 1u); break; } } } } while (0)
struct XcdBarrier { unsigned* bar; unsigned x; volatile LAS unsigned* st; };
DI void xcd_barrier_post(unsigned* bar) { if (threadIdx.x == 0) (void)xb_add(&bar[XB_XCNT(xb_xcc_id())], 1u); }
DI void xcd_barrier_complete(unsigned* bar, unsigned x, unsigned& nloc, unsigned& nx) {
    const unsigned G = gridDim.x * gridDim.y * gridDim.z;
    unsigned sum, cnt, mine, sp = 0u;
    for (;;) {
        sum = 0u; cnt = 0u; mine = 0u;
#pragma unroll
        for (unsigned j = 0; j < 16; ++j) { const unsigned c = xb_ld(&bar[XB_XCNT(j)]); sum += c; cnt += (c > 0u) ? 1u : 0u; mine = (j == x) ? c : mine; }
        if (sum == G) break;
        __builtin_amdgcn_s_sleep(1);
        if ((++sp & 255u) == 0u) { if (xb_ld(&bar[XB_TMO])) break; if (sp > XB_SPIN_CAP) { atomicAdd(&bar[XB_TMO], 1u); break; } }
    }
    nloc = mine > 0u ? mine : 1u; nx = cnt > 0u ? cnt : 1u;
}
DI void xcd_barrier(const XcdBarrier& b) {
    asm volatile("s_waitcnt vmcnt(0)" ::: "memory");
    __syncthreads();
    if (threadIdx.x == 0) {
        unsigned* bar = b.bar;
        __builtin_amdgcn_s_waitcnt(0);
        unsigned nloc = b.st[0], nx = b.st[1];
        if (nloc == 0u) { xcd_barrier_complete(bar, b.x, nloc, nx); b.st[0] = nloc; b.st[1] = nx; }
        const unsigned old = xb_add(&bar[XB_XSUB(b.x)], 1u);
        const unsigned gen = old / nloc;
        if (old + 1u == (gen + 1u) * nloc) {
            __builtin_amdgcn_fence(__ATOMIC_RELEASE, "agent");
            asm volatile("s_waitcnt vmcnt(0)" ::: "memory");
            const unsigned og = xb_add(&bar[XB_TOP], 1u);
            const unsigned tg = og / nx;
            if (og + 1u == (tg + 1u) * nx) xb_add(&bar[XB_TOPGEN], 1u);
            else XB_SPIN(xb_ld(&bar[XB_TOPGEN]) == tg, bar);
            __builtin_amdgcn_fence(__ATOMIC_ACQUIRE, "agent");
            xb_add(&bar[XB_XGEN(b.x)], 1u);
            asm volatile("s_waitcnt vmcnt(0)" ::: "memory");
        } else {
            XB_SPIN(xb_ld(&bar[XB_XGEN(b.x)]) == gen, bar);
            __builtin_amdgcn_fence(__ATOMIC_ACQUIRE, "agent");
            asm volatile("s_waitcnt vmcnt(0)" ::: "memory");
        }
    }
    __syncthreads();
}

__global__ void __launch_bounds__(512, 2) mega(Params p_unused) {
    extern __shared__ __attribute__((aligned(16))) unsigned char lds_raw[];
    LAS unsigned char* lds = (LAS unsigned char*)lds_raw;
    cg::grid_group grid = cg::this_grid();
    #define RUN(k) (PRM.ph_lo <= (k) && (k) < PRM.ph_hi)
#define SEAM_ALWAYS() do { XcdBarrier xb_{(unsigned*)(LP(PRM.ws) + WS_BAR), xb_xcc_id(), (volatile LAS unsigned*)(lds + LDS_BYTES - 16)}; xcd_barrier(xb_); } while (0)
#define SEAM(k) do { if (PRM.coop && RUN(k) && RUN((k) + 1)) { XcdBarrier xb_{(unsigned*)(LP(PRM.ws) + WS_BAR), xb_xcc_id(), (volatile LAS unsigned*)(lds + LDS_BYTES - 16)}; xcd_barrier(xb_); } } while (0)
    if (PRM.coop == 2) grid.sync();
    { volatile LAS unsigned* stw = (volatile LAS unsigned*)(lds + LDS_BYTES - 16); if (threadIdx.x == 0) { stw[0] = 0u; stw[1] = 0u; } __syncthreads();
      if (PRM.coop) xcd_barrier_post((unsigned*)(LP(PRM.ws) + WS_BAR)); }
#if REPK == 20
    if (PRM.coop) for (int i = 0; i < 20; ++i) SEAM_ALWAYS();
#endif
    for (int l = 0; l < 2; ++l) {
        const int P = l * 10;
        const bool last = (l == 1);
        const float lam_init = 0.8f - 0.6f * __expf(-0.3f * (float)l);
#ifndef NO_PREP
        if (RUN(P + 0)) for (int rep = 0; rep < NREP(0); ++rep) phase_prep(lds, l);
#endif
        if (l == 0) SEAM(P + 0);
        if (RUN(P + 1)) for (int rep = 0; rep < NREP(1); ++rep) phase_norm(l, 0, false, l == 1 ? 2 : 0, 0, 5, l == 0 ? (const void*)PRM.in[I_X] : (const void*)PRM.out, l == 0 ? 0 : 1);
        SEAM(P + 1);
        if (RUN(P + 2)) for (int rep = 0; rep < NREP(2); ++rep) {
            pg8::Gemm g{(const bf16_t*)(LP(PRM.ws) + WS_A), (const bf16_t*)(LP(PRM.ws) + WS_WIN), DM, DM, DM};
            pg8::Order S; S.init(MROWS / 256, NIN / 256, GDIM(), BID(), 0);
            pg8::EpiBf16<0> E{(bf16_t*)(LP(PRM.ws) + WS_QB), 1024, 1};
            pg8::gemm_phase(lds, g, S, E);
        }
        SEAM(P + 2);
#ifndef NO_POST
        if (RUN(P + 3)) for (int rep = 0; rep < NREP(3); ++rep) phase_post(lds, l, rep == 0);
#endif
        SEAM(P + 3);
        if (RUN(P + 4)) {
            gla_scan();
#if REPK == 11
            if (l == 0) { SEAM_ALWAYS(); for (int u = BID(); u < NB * 4 * NCH; u += GDIM()) { const int c = u % NCH, h = (u / NCH) & 3, b = u / (4 * NCH); gla_g1_unit(lds, l, b, h, c); } SEAM_ALWAYS(); gla_scan(); }
#endif
#if REPK == 12
            if (l == 0) { SEAM_ALWAYS(); for (int u = BID(); u < NB * 4 * NCH; u += GDIM()) { const int c = u % NCH, h = (u / NCH) & 3, b = u / (4 * NCH); gla_g1_unit(lds, l, b, h, c); } SEAM_ALWAYS(); }
#endif
            for (int rep = 0; rep < NREP(4); ++rep) {
            {
                pg8::Gemm g{(const bf16_t*)(LP(PRM.ws) + WS_A1), (const bf16_t*)(LP(PRM.ws) + WS_UTL), 128, 128, 128};
                pg8::Order S; S.init(1, 256, GDIM(), BID(), 0);
                pg8::EpiDft1 E{(bf16_t*)(LP(PRM.ws) + WS_B2T)};
                pg8::gemm_phase(lds, g, S, E);
            }
            if (!last) {
                pg8::Gemm g{(const bf16_t*)(LP(PRM.ws) + WS_TCTX), (const bf16_t*)(LP(PRM.ws) + WS_UTC), 256, 256, 256};
                pg8::Order S; S.init(2, 4, 8, BID() - 116, 0);
                pg8::EpiDftCtx E{(bf16_t*)(LP(PRM.ws) + WS_PQ)};
                pg8::gemm_phase(lds, g, S, E);
            }
            __syncthreads();
            if (PRM.coop) SEAM_ALWAYS();
            {
                pg8::Gemm g{(const bf16_t*)(LP(PRM.ws) + WS_A2), (const bf16_t*)(LP(PRM.ws) + WS_B2T), 128, 128, 128};
                pg8::Order S; S.init(1, 512, GDIM(), BID(), 0);
                pg8::EpiDft2 E{(bf16_t*)(LP(PRM.ws) + WS_PQ)};
                pg8::gemm_phase(lds, g, S, E);
            }
            __syncthreads();
#ifndef NO_ATT
            {
                const float* qg = PRM.in[I_QG] + l * 64; const float* kgv = PRM.in[I_KG] + l * 64; const float* lp = PRM.in[I_LAM] + l * 256;
                float mq = 0.f, mk = 0.f, s01 = 0.f, s23 = 0.f;
                for (int i = 0; i < 64; ++i) { mq = fmaxf(mq, fabsf(qg[i])); mk = fmaxf(mk, fabsf(kgv[i])); s01 += lp[i] * lp[64 + i]; s23 += lp[128 + i] * lp[192 + i]; }
                const float shift2 = 8.f * mq * mk * LOG2E * 1.02f;
                const float lam = __builtin_bit_cast(float, __builtin_amdgcn_readfirstlane(__builtin_bit_cast(int, __expf(s01) - __expf(s23) + lam_init)));
                const int lam_init_bits = __builtin_amdgcn_readfirstlane(__builtin_bit_cast(int, lam_init));
                const int nun = last ? 512 : 528;
                const int G = GDIM(), bx = BID(); const int vcu = (G % 8 == 0) ? (bx % 8) * (G / 8) + bx / 8 : bx;
                for (int u = vcu; u < nun; u += G) {
                    int b, h, qt;
                    if (u < 512) { b = u >> 8; h = (u >> 5) & 7; qt = (u & 31) + 1; } else { const int v = u - 512; b = v >> 3; h = v & 7; qt = 0; }
                    att::attn_unit<false>(lds, (const bf16_t*)(LP(PRM.ws) + WS_QB), (const bf16_t*)(LP(PRM.ws) + WS_KB), (const bf16_t*)(LP(PRM.ws) + WS_VT), (bf16_t*)(LP(PRM.ws) + WS_A), b, h, qt, 0.f, lam, lam_init_bits, PRM.in[I_SUBLN] + l * 128);
                }
            }
#endif
            }
        }
        SEAM(P + 4);
        if (RUN(P + 5)) {
#ifndef NO_G3
            { const int G_ = GDIM(), bx_ = BID(); const int nlat = NB * 4 * 128;
              for (int u = bx_; ; u += G_) { int b, h, c;
                  if (u < nlat) { c = 4 + (u & 127); h = (u >> 7) & 3; b = u >> 9; }
                  else { const int v = bx_ - (G_ - 32); if (last || v < 0) break; c = v & 3; h = (v >> 2) & 3; b = (v >> 4) & 1; }
                  gla_g3_unit(lds, l, b, h, c);
                  if (u >= nlat) break; } }
#endif
            __syncthreads();
            {
                pg8::Gemm g{(const bf16_t*)(LP(PRM.ws) + WS_PQ), (const bf16_t*)(LP(PRM.ws) + WS_WCS), 1024, 1024, 1024};
                pg8::Order S; if (last) S.init(64, 2, GDIM(), BID(), 1); else S.init(66, 2, GDIM(), BID(), 0);
                pg8::EpiBf16<0> E{(bf16_t*)(LP(PRM.ws) + WS_A) + 1536, DM, 0};
                pg8::gemm_phase(lds, g, S, E);
            }
        }
        SEAM(P + 5);
        if (RUN(P + 6)) for (int rep = 0; rep < NREP(6); ++rep) {
            pg8::Gemm g{(const bf16_t*)(LP(PRM.ws) + WS_A), (const bf16_t*)(LP(PRM.ws) + WS_WOUT), DM, DM, DM};
            pg8::Order S; S.init(64, 8, GDIM(), BID(), 1);
            pg8::EpiResid E{l == 0 ? (const void*)PRM.in[I_X] : (const void*)PRM.out, l == 0 ? (void*)PRM.out : (void*)(LP(PRM.ws) + WS_KV), (const float*)(LP(PRM.ws) + WS_MOD) + (size_t)l * 3 * 12288 + 2 * DM, l == 0 ? 0 : 1, 1};
            pg8::gemm_phase(lds, g, S, E);
            if (!last) {
                pg8::Gemm g2{(const bf16_t*)(LP(PRM.ws) + WS_A), (const bf16_t*)(LP(PRM.ws) + WS_WOUT), DM / NSPLIT, DM, DM};
                pg8::Order S2; S2.init(2, 8, GDIM(), BID(), 2, NSPLIT, DM / NSPLIT);
                pg8::EpiPartial E2{(float*)(LP(PRM.ws) + WS_PART), DM / NSPLIT};
                pg8::gemm_phase(lds, g2, S2, E2);
            }
        }
        SEAM(P + 6);
        if (RUN(P + 7)) phase_norm(l, 1, last, last ? 0 : 1, l, 2, l == 0 ? (const void*)PRM.out : (const void*)(LP(PRM.ws) + WS_KV), 1);
        SEAM(P + 7);
        if (RUN(P + 8)) for (int rep = 0; rep < NREP(8); ++rep) {
            pg8::Gemm g{(const bf16_t*)(LP(PRM.ws) + WS_A), (const bf16_t*)(LP(PRM.ws) + WS_WFF1), DM, DM, DM};
            pg8::Order S; if (last) S.init(64, 32, GDIM(), BID(), 1); else S.init(66, 32, GDIM(), BID(), 0);
            pg8::EpiBf16<1> E{(bf16_t*)(LP(PRM.ws) + WS_H), DFF, 0};
            pg8::gemm_phase(lds, g, S, E);
        }
        SEAM(P + 8);
        if (RUN(P + 9)) {
            pg8::Gemm g{(const bf16_t*)(LP(PRM.ws) + WS_H), (const bf16_t*)(LP(PRM.ws) + WS_WFF2), DFF, DFF, DFF};
            pg8::Order S; S.init(64, 8, GDIM(), BID(), 1);
            pg8::EpiResid E{l == 0 ? (const void*)PRM.out : (const void*)(LP(PRM.ws) + WS_KV), (void*)PRM.out, (const float*)(LP(PRM.ws) + WS_MOD) + (size_t)l * 3 * 12288 + 5 * DM, 1, l == 0 ? 1 : 0};
            pg8::gemm_phase(lds, g, S, E);
            if (NREP(9) == 2) {
                pg8::Gemm g3{(const bf16_t*)(LP(PRM.ws) + WS_H), (const bf16_t*)(LP(PRM.ws) + WS_WFF2), DFF, DFF, DFF};
                pg8::Order S3; S3.init(64, 8, GDIM(), BID(), 1);
                pg8::EpiBf16<0> E3{(bf16_t*)(LP(PRM.ws) + WS_T + ((size_t)64 << 20)), DM, 0};
                pg8::gemm_phase(lds, g3, S3, E3);
            }
            if (!last) {
                pg8::Gemm g2{(const bf16_t*)(LP(PRM.ws) + WS_H), (const bf16_t*)(LP(PRM.ws) + WS_WFF2), DFF / NSPLIT, DFF, DFF};
                pg8::Order S2; S2.init(2, 8, GDIM(), BID(), 2, NSPLIT, DFF / NSPLIT);
                pg8::EpiPartial E2{(float*)(LP(PRM.ws) + WS_PART), DFF / NSPLIT};
                pg8::gemm_phase(lds, g2, S2, E2);
            }
        }
        SEAM(P + 9);
    }
}

extern "C" void kernel_launch(void* const* d_in, const int* in_sizes, int n_in, void* d_out, int out_size, void* d_ws, size_t ws_size, hipStream_t stream) {
    static int grid = 0;
    if (grid == 0) {
        if (n_in != 20 || out_size != NB * SEQ * DM || ws_size < WS_END) { fprintf(stderr, "kernel_launch: unexpected problem (n_in %d out %d ws %zu need %zu)\n", n_in, out_size, ws_size, (size_t)WS_END); grid = -1; return; }
        int dev = 0, cus = 0, per_cu = 0;
        hipGetDevice(&dev); hipDeviceGetAttribute(&cus, hipDeviceAttributeMultiprocessorCount, dev);
        if (hipFuncSetAttribute((const void*)mega, hipFuncAttributeMaxDynamicSharedMemorySize, LDS_BYTES) != hipSuccess) { fprintf(stderr, "kernel_launch: hipFuncSetAttribute failed\n"); grid = -1; return; }
        if (hipOccupancyMaxActiveBlocksPerMultiprocessor(&per_cu, (const void*)mega, 512, LDS_BYTES) != hipSuccess || per_cu < 1) { fprintf(stderr, "kernel_launch: occupancy query says %d\n", per_cu); per_cu = 1; }
        (void)hipGetLastError();
        grid = cus;
    }
    if (grid < 0) return;
    Params p{};
    for (int i = 0; i < 20; ++i) p.in[i] = (const float*)d_in[i];
    p.out = (float*)d_out; p.ws = (unsigned char*)d_ws; p.ph_lo = 0; p.ph_hi = 20; p.coop = 1; p.pad = 0;
    if (hipMemsetAsync((char*)d_ws + WS_BAR, 0, 16384, stream) != hipSuccess) { fprintf(stderr, "kernel_launch: memset of barrier words failed\n"); return; }
    void* args[] = {&p};
    hipError_t e = hipLaunchCooperativeKernel((const void*)mega, dim3(grid), dim3(512), args, LDS_BYTES, stream);
    if (e != hipSuccess) fprintf(stderr, "cooperative launch failed: %s (grid %d)\n", hipGetErrorString(e), grid);
}
```

```cpp
#include <hip/hip_runtime.h>
#include <hip/hip_cooperative_groups.h>
#include <cstdio>
#include <cstdint>
namespace cg = cooperative_groups;

#define LAS __attribute__((address_space(3)))
typedef unsigned short bf16_t;
typedef short bf16x8 __attribute__((ext_vector_type(8)));
typedef float f32x4 __attribute__((ext_vector_type(4)));
typedef float f32x16 __attribute__((ext_vector_type(16)));
typedef unsigned u32x4 __attribute__((ext_vector_type(4)));
typedef unsigned u32x2 __attribute__((ext_vector_type(2)));
#define DI __device__ __forceinline__
#define LDS_WAIT() asm volatile("s_waitcnt lgkmcnt(0)" ::: "memory")

constexpr int DM = 2048, NB = 2, SEQ = 8192, CTXL = 256, TPB = SEQ + CTXL  , MROWS = NB * TPB  ;
constexpr int DIN = 5152, NIN = 5376, DFF = 8192, P2W = 2304, NCH = TPB / 64  ;
constexpr float EPS = 1e-6f;
constexpr float QSCALE = 0.18033688011112042f;
constexpr float LOG2E = 1.4426950408889634f;

constexpr size_t al256(size_t x) { return (x + 255) & ~(size_t)255; }
constexpr size_t WS_MOD = 0;
constexpr size_t WS_XC = al256(WS_MOD + (size_t)2 * 3 * 12288 * 4);
constexpr size_t WS_WIN = al256(WS_XC + (size_t)512 * DM * 4);
constexpr size_t WS_WOUT = al256(WS_WIN + (size_t)NIN * DM * 2);
constexpr size_t WS_WFF1 = al256(WS_WOUT + (size_t)DM * DM * 2);
constexpr size_t WS_WFF2 = al256(WS_WFF1 + (size_t)DFF * DM * 2);
constexpr size_t WS_WCS = al256(WS_WFF2 + (size_t)DM * DFF * 2);
constexpr size_t WS_TCTX = al256(WS_WCS + (size_t)512 * 1024 * 2);
constexpr size_t WS_A = al256(WS_TCTX + (size_t)512 * 256 * 2);
constexpr size_t WS_QB = al256(WS_A + (size_t)MROWS * DM * 2);
constexpr size_t WS_KB = al256(WS_QB + (size_t)MROWS * 1024 * 2);
constexpr size_t WS_VB = al256(WS_KB + (size_t)MROWS * 1024 * 2);
constexpr size_t WS_VT = al256(WS_VB + (size_t)MROWS * 1024 * 2);
constexpr size_t WS_P2 = al256(WS_VT + (size_t)MROWS * 1024 * 2);
constexpr size_t WS_T = al256(WS_P2 + (size_t)MROWS * P2W * 2);
constexpr size_t WS_B2T = WS_T;
constexpr size_t WS_A1 = WS_T + ((size_t)100 << 20);
constexpr size_t WS_A2 = WS_A1 + 65536;
constexpr size_t WS_H = WS_QB;
constexpr size_t WS_UTL = al256(WS_T + (size_t)8448 * 8192 * 2);
constexpr size_t WS_UTC = al256(WS_UTL + (size_t)1024 * 8192 * 2);
constexpr size_t WS_PQ = al256(WS_UTC + (size_t)1024 * 256 * 2);
constexpr size_t WS_KV = al256(WS_PQ + (size_t)MROWS * 1024 * 2);
constexpr size_t WS_DEC = al256(WS_KV + (size_t)16 * NCH * 8192 * 4);
constexpr size_t WS_PART = al256(WS_DEC + (size_t)16 * NCH * 64 * 4);
constexpr size_t WS_BAR = al256(WS_PART + (size_t)8 * 512 * DM * 4);
constexpr size_t WS_END = WS_BAR + 16384;
constexpr int NSPLIT = 8;
static_assert(WS_H + (size_t)MROWS * DFF * 2 <= WS_UTL, "H overlay must end before UTL");
static_assert(WS_KB - WS_QB == (size_t)MROWS * 2048 && WS_VB - WS_KB == (size_t)MROWS * 2048 && WS_P2 - WS_QB == 4 * (size_t)MROWS * 2048, "in-proj destinations at fixed strides");

constexpr int LDS_BYTES = 160768;
#ifndef REPK
#define REPK -1
#endif
#define NREP(k) ((l == 0 && (k) == REPK) ? 2 : 1)

DI unsigned f2bf(float f) { unsigned u = __builtin_bit_cast(unsigned, f); return (u + 0x7fffu + ((u >> 16) & 1u)) >> 16; }
DI unsigned pk2(float lo, float hi) { return f2bf(lo) | (f2bf(hi) << 16); }
DI float bf2f(unsigned h) { return __builtin_bit_cast(float, h << 16); }
DI unsigned cvt_pk_bf16(float lo, float hi) { unsigned r; asm volatile("v_cvt_pk_bf16_f32 %0, %1, %2" : "=v"(r) : "v"(lo), "v"(hi)); return r; }
DI int TID() { int t = threadIdx.x; asm volatile("" : "+v"(t)); return t; }
DI int BID() { int t = blockIdx.x; asm volatile("" : "+s"(t)); return t; }
DI int GDIM() { int t = gridDim.x; asm volatile("" : "+s"(t)); return t; }
template <class T> DI T* LP(T* p) { asm volatile("" : "+s"(p)); return p; }
DI float wave_sum(float v) {
#pragma unroll
    for (int o = 1; o < 64; o <<= 1) v += __shfl_xor(v, o);
    return v;
}
DI float logsig(float z) { return fminf(z, 0.f) - __logf(1.f + __expf(-fabsf(z))); }

namespace pg8 {
constexpr int BM = 256, BK = 64, HALF = 128, HTB = HALF * BK * 2, STAGE_BYTES = 8 * HTB, NXCD = 8, WGM = 8;
DI int lds_byte(int r, int c) { const int st = (r >> 4) * 2 + (c >> 5), rr = r & 15, cc = c & 31, ob = rr * 64 + cc * 2; return st * 1024 + (ob ^ (((ob >> 9) & 1) << 5)); }
DI void stage_rc(int b, int& R, int& C) { const int st = b / 1024, sb = b % 1024, swz = sb ^ (((sb >> 9) & 1) << 5); R = (st >> 1) * 16 + swz / 64; C = (st & 1) * 32 + (swz % 64) / 2; }
DI int perm32(int rho) { const int n = rho >> 4, i = rho & 15; return 8 * (i >> 2) + 4 * n + (i & 3); }
struct Unit { int pm, pn, ko; };
struct Gemm { const bf16_t* A; const bf16_t* Bt; int K, lda, ldb; };
struct Order {
    int nM, nN, nwg, G, c, skip, nK, ksub;
    DI void init(int nM_, int nN_, int G_, int c_, int skip_, int nK_ = 1, int ksub_ = 0) { nM = nM_; nN = nN_; nwg = nM * nN; G = G_; c = c_; skip = skip_; nK = nK_; ksub = ksub_; }
    DI bool next(int i, Unit& u) const {
        if (c < 0 || c >= G) return false;
        const int L = i * G + c; if (L >= nwg * nK) return false;
        int wgid = L % nwg; u.ko = (L / nwg) * ksub;
        { const int q = nwg / NXCD, r = nwg % NXCD, xcd = wgid % NXCD, off = wgid / NXCD; wgid = (xcd < r ? xcd * (q + 1) : r * (q + 1) + (xcd - r) * q) + off; }
        const int nig = WGM * nN, gid = wgid / nig, fm = gid * WGM, gsz = (nM - fm) < WGM ? (nM - fm) : WGM;
        int pm = fm + ((wgid % nig) % gsz); u.pn = (wgid % nig) / gsz;
        if (skip == 1) pm = pm + 1 + (pm >= 32 ? 1 : 0);
        if (skip == 2) pm = pm * 33;
        u.pm = pm; return true;
    }
};

template <class Epi>
DI void gemm_phase(LAS unsigned char* lds, const Gemm g, const Order& S, const Epi& E) {
    const int tid = TID(), wid = __builtin_amdgcn_readfirstlane(tid >> 6), lane = tid & 63, wr = wid >> 2, wc = wid & 3, fr = lane & 15, fq = lane >> 4;
    int K = g.K; asm volatile("" : "+s"(K));
    const int nt = K / BK;
    unsigned voffA[2], voffB[2];
#pragma unroll
    for (int i = 0; i < 2; ++i) { int R, C; stage_rc(tid * 16 + i * 8192, R, C); const int Rb = Epi::PERM ? ((R & ~31) + perm32(R & 31)) : R;
        voffA[i] = (unsigned)(R * g.lda + C) * 2u; voffB[i] = (unsigned)(Rb * g.ldb + C) * 2u; }
    const size_t kstep = (size_t)(BK * 2);
    const size_t hstepA = (size_t)HALF * g.lda * 2, hstepB = (size_t)HALF * g.ldb * 2;
    const size_t tstepA = 2 * hstepA, tstepB = 2 * hstepB;
    const unsigned ldsw = (unsigned)wid * 1024u;
    const int aoff = lds_byte(wr * 64 + fr, fq * 8), boff = lds_byte(wc * 32 + fr, fq * 8);
#define PG8_SA(b, h) (((b) * 2 + (h)) * HTB)
#define PG8_SB(b, h) ((4 + (b) * 2 + (h)) * HTB)
#define PG8_STAGE(bufoff, gbase, voff) do { _Pragma("unroll") for (int _i = 0; _i < 2; ++_i) \
        __builtin_amdgcn_global_load_lds((const unsigned*)((const char*)(gbase) + (voff)[_i]), (LAS unsigned*)(lds + (bufoff) + ldsw + _i * 8192), 16, 0, 0); } while (0)
#define PG8_LDA(dst, b, h) do { _Pragma("unroll") for (int m = 0; m < 4; ++m) _Pragma("unroll") for (int k = 0; k < 2; ++k) dst[m][k] = *(const LAS bf16x8*)(lds + PG8_SA(b, h) + aoff + m * 2048 + k * 1024); } while (0)
#define PG8_LDB(dst, b, h) do { _Pragma("unroll") for (int n = 0; n < 2; ++n) _Pragma("unroll") for (int k = 0; k < 2; ++k) dst[n][k] = *(const LAS bf16x8*)(lds + PG8_SB(b, h) + boff + n * 2048 + k * 1024); } while (0)
#define PG8_MMA(ai, bj, At, Bt) do { __builtin_amdgcn_s_setprio(1); _Pragma("unroll") for (int m = 0; m < 4; ++m) _Pragma("unroll") for (int n = 0; n < 2; ++n) _Pragma("unroll") for (int k = 0; k < 2; ++k) \
        acc[ai][bj][m][n] = __builtin_amdgcn_mfma_f32_16x16x32_bf16(Bt[n][k], At[m][k], acc[ai][bj][m][n], 0, 0, 0); __builtin_amdgcn_s_setprio(0); } while (0)
#define PG8_WAIT_V(n) asm volatile("s_waitcnt vmcnt(" #n ")" ::: "memory")
#define PG8_WAIT_L(n) asm volatile("s_waitcnt lgkmcnt(" #n ")" ::: "memory")
#define PG8_BAR __builtin_amdgcn_s_barrier()
#define PG8_SCHED __builtin_amdgcn_sched_barrier(0)
    Unit cur, nxt; int ui = 0;
    if (!S.next(0, cur)) return;
    f32x4 acc[2][2][4][2];
#pragma unroll
    for (int a = 0; a < 2; ++a)
#pragma unroll
        for (int b = 0; b < 2; ++b)
#pragma unroll
            for (int m = 0; m < 4; ++m)
#pragma unroll
                for (int n = 0; n < 2; ++n) acc[a][b][m][n] = (f32x4){0.f, 0.f, 0.f, 0.f};
    bf16x8 At[4][2], B0[2][2], B1[2][2];
    const char* cA = (const char*)g.A + (size_t)cur.pm * tstepA + (size_t)cur.ko * 2; const char* cB = (const char*)g.Bt + (size_t)cur.pn * tstepB + (size_t)cur.ko * 2;
    PG8_STAGE(PG8_SB(0, 0), cB, voffB); PG8_STAGE(PG8_SB(0, 1), cB + hstepB, voffB); PG8_STAGE(PG8_SA(0, 0), cA, voffA); PG8_STAGE(PG8_SA(0, 1), cA + hstepA, voffA);
    if (wr == 1) PG8_BAR;
    PG8_WAIT_V(2); PG8_BAR;
    PG8_STAGE(PG8_SB(1, 0), cB + kstep, voffB); PG8_STAGE(PG8_SA(1, 0), cA + kstep, voffA); PG8_STAGE(PG8_SB(1, 1), cB + hstepB + kstep, voffB);
    PG8_WAIT_V(6); PG8_BAR;
    for (;;) {
        const bool has_next = S.next(ui + 1, nxt);
        const char* nA = has_next ? (const char*)g.A + (size_t)nxt.pm * tstepA + (size_t)nxt.ko * 2 : cA; const char* nB = has_next ? (const char*)g.Bt + (size_t)nxt.pn * tstepB + (size_t)nxt.ko * 2 : cB;
        for (int t = 0; t < nt; t += 2) {
            const bool last = (t == nt - 2);
            const char* a1 = cA + (size_t)(t + 1) * kstep;
            const char* a2 = last ? nA : cA + (size_t)(t + 2) * kstep; const char* b2 = last ? nB : cB + (size_t)(t + 2) * kstep;
            const char* a3 = a2 + kstep; const char* b3 = b2 + kstep;
            PG8_LDB(B0, 0, 0); PG8_LDB(B1, 0, 1); PG8_SCHED; PG8_LDA(At, 0, 0); PG8_STAGE(PG8_SA(1, 1), a1 + hstepA, voffA);
            PG8_WAIT_V(8); PG8_WAIT_L(0); PG8_BAR; PG8_MMA(0, 0, At, B0); PG8_MMA(0, 1, At, B1); PG8_BAR; PG8_SCHED;
            PG8_LDA(At, 0, 1); PG8_STAGE(PG8_SB(0, 0), b2, voffB); PG8_STAGE(PG8_SB(0, 1), b2 + hstepB, voffB); PG8_STAGE(PG8_SA(0, 0), a2, voffA);
            PG8_WAIT_V(8); PG8_WAIT_L(0); PG8_BAR; PG8_MMA(1, 0, At, B0); PG8_MMA(1, 1, At, B1); PG8_BAR; PG8_SCHED;
            PG8_LDB(B0, 1, 0); PG8_LDB(B1, 1, 1); PG8_SCHED; PG8_LDA(At, 1, 0); PG8_STAGE(PG8_SA(0, 1), a2 + hstepA, voffA);
            PG8_WAIT_V(8); PG8_WAIT_L(0); PG8_BAR; PG8_MMA(0, 0, At, B0); PG8_MMA(0, 1, At, B1); PG8_BAR; PG8_SCHED;
            PG8_LDA(At, 1, 1); PG8_STAGE(PG8_SB(1, 0), b3, voffB); PG8_STAGE(PG8_SB(1, 1), b3 + hstepB, voffB); PG8_STAGE(PG8_SA(1, 0), a3, voffA);
            PG8_WAIT_V(8); PG8_WAIT_L(0); PG8_BAR; PG8_MMA(1, 0, At, B0); PG8_MMA(1, 1, At, B1); PG8_BAR; PG8_SCHED;
        }
        if (wr == 0) PG8_BAR;
        E(acc, cur, wr, wc, fr, fq);
        if (!has_next) break;
#pragma unroll
        for (int a = 0; a < 2; ++a)
#pragma unroll
            for (int b = 0; b < 2; ++b)
#pragma unroll
                for (int m = 0; m < 4; ++m)
#pragma unroll
                    for (int n = 0; n < 2; ++n) acc[a][b][m][n] = (f32x4){0.f, 0.f, 0.f, 0.f};
        cur = nxt; cA = nA; cB = nB; ++ui;
        if (wr == 1) PG8_BAR;
    }
    PG8_WAIT_V(0);
    PG8_BAR;
#undef PG8_SA
#undef PG8_SB
#undef PG8_STAGE
#undef PG8_LDA
#undef PG8_LDB
#undef PG8_MMA
#undef PG8_WAIT_V
#undef PG8_WAIT_L
#undef PG8_BAR
#undef PG8_SCHED
}

template <int ACT> struct EpiBf16 {
    static constexpr bool PERM = true;
    bf16_t* d0; int ld0; int split;
    DI void operator()(const f32x4 (&acc)[2][2][4][2], const Unit& u, int wr, int wc, int fr_, int fq_) const {
        int fr = fr_, fq = fq_; asm volatile("" : "+v"(fr), "+v"(fq));
        bf16_t* base = d0; int ldc = ld0, t0 = 0;
        if (split) { const int sg = (u.pn >> 2) < 3 ? (u.pn >> 2) : 3; base = d0 + (size_t)(sg < 3 ? sg : 4) * ((size_t)MROWS * 1024); ldc = sg < 3 ? 1024 : P2W; t0 = sg * 4; }
        const int row0 = u.pm * BM + wr * 64 + fr, col0 = (u.pn - t0) * BM + wc * 32 + 8 * fq;
#pragma unroll
        for (int ai = 0; ai < 2; ++ai)
#pragma unroll
            for (int m = 0; m < 4; ++m) { bf16_t* rowp = base + (size_t)(row0 + ai * HALF + m * 16) * ldc + col0;
#pragma unroll
                for (int bj = 0; bj < 2; ++bj) { f32x4 v0 = acc[ai][bj][m][0], v1 = acc[ai][bj][m][1];
                    if (ACT == 1) {
#pragma unroll
                        for (int j = 0; j < 4; ++j) { const float a = fmaxf(v0[j], 0.f), b = fmaxf(v1[j], 0.f); v0[j] = a * a; v1[j] = b * b; } }
                    u32x4 w; w.x = cvt_pk_bf16(v0[0], v0[1]); w.y = cvt_pk_bf16(v0[2], v0[3]); w.z = cvt_pk_bf16(v1[0], v1[1]); w.w = cvt_pk_bf16(v1[2], v1[3]);
                    *(u32x4*)(rowp + bj * HALF) = w; } }
    }
};
struct EpiResid {
    static constexpr bool PERM = true;
    const void* src; void* dst; const float* gate; int sb, db;
    DI void operator()(const f32x4 (&acc)[2][2][4][2], const Unit& u, int wr, int wc, int fr_, int fq_) const {
        int fr = fr_, fq = fq_; asm volatile("" : "+v"(fr), "+v"(fq));
        const int b = u.pm / 33, tt = u.pm % 33;
        const size_t roff = ((size_t)b * SEQ + (size_t)(tt - 1) * 256) * DM;
        const float* gp = gate + (size_t)b * 12288;
        const int col0 = u.pn * BM + wc * 32 + 8 * fq;
        f32x4 gq[2][2];
#pragma unroll
        for (int bj = 0; bj < 2; ++bj) { gq[bj][0] = *(const f32x4*)(gp + col0 + bj * HALF); gq[bj][1] = *(const f32x4*)(gp + col0 + bj * HALF + 4); }
        if (sb) {
#pragma unroll
            for (int ai = 0; ai < 2; ++ai) {
                u32x4 pre[4][2];
#pragma unroll
                for (int m = 0; m < 4; ++m) { const size_t off = roff + (size_t)(ai * HALF + wr * 64 + m * 16 + fr) * DM + col0;
#pragma unroll
                    for (int bj = 0; bj < 2; ++bj) pre[m][bj] = *(const u32x4*)((const bf16_t*)src + off + bj * HALF); }
#pragma unroll
                for (int m = 0; m < 4; ++m) { const size_t off = roff + (size_t)(ai * HALF + wr * 64 + m * 16 + fr) * DM + col0;
#pragma unroll
                    for (int bj = 0; bj < 2; ++bj) { const int cc = bj * HALF; const u32x4 w = pre[m][bj];
                        const f32x4 s0 = (f32x4){bf2f(w.x & 0xffff), bf2f(w.x >> 16), bf2f(w.y & 0xffff), bf2f(w.y >> 16)}, s1 = (f32x4){bf2f(w.z & 0xffff), bf2f(w.z >> 16), bf2f(w.w & 0xffff), bf2f(w.w >> 16)};
                        const f32x4 o0 = s0 + gq[bj][0] * acc[ai][bj][m][0], o1 = s1 + gq[bj][1] * acc[ai][bj][m][1];
                        if (db) { u32x4 o; o.x = cvt_pk_bf16(o0[0], o0[1]); o.y = cvt_pk_bf16(o0[2], o0[3]); o.z = cvt_pk_bf16(o1[0], o1[1]); o.w = cvt_pk_bf16(o1[2], o1[3]); *(u32x4*)((bf16_t*)dst + off + cc) = o; }
                        else { *(f32x4*)((float*)dst + off + cc) = o0; *(f32x4*)((float*)dst + off + cc + 4) = o1; } } }
                asm volatile("" ::: "memory"); }
        } else {
#pragma unroll
            for (int ai = 0; ai < 2; ++ai)
#pragma unroll
                for (int m = 0; m < 4; ++m) { const size_t off = roff + (size_t)(ai * HALF + wr * 64 + m * 16 + fr) * DM + col0;
#pragma unroll
                    for (int bj = 0; bj < 2; ++bj) { const int cc = bj * HALF;
                        const f32x4 s0 = *(const f32x4*)((const float*)src + off + cc), s1 = *(const f32x4*)((const float*)src + off + cc + 4);
                        const f32x4 o0 = s0 + gq[bj][0] * acc[ai][bj][m][0], o1 = s1 + gq[bj][1] * acc[ai][bj][m][1];
                        if (db) { u32x4 o; o.x = cvt_pk_bf16(o0[0], o0[1]); o.y = cvt_pk_bf16(o0[2], o0[3]); o.z = cvt_pk_bf16(o1[0], o1[1]); o.w = cvt_pk_bf16(o1[2], o1[3]); *(u32x4*)((bf16_t*)dst + off + cc) = o; }
                        else { *(f32x4*)((float*)dst + off + cc) = o0; *(f32x4*)((float*)dst + off + cc + 4) = o1; } }
                    if (m & 1) asm volatile("" ::: "memory"); }
        }
    }
};
struct EpiPartial {
    static constexpr bool PERM = true;
    float* part; int ksub;
    DI void operator()(const f32x4 (&acc)[2][2][4][2], const Unit& u, int wr, int wc, int fr_, int fq_) const {
        int fr = fr_, fq = fq_; asm volatile("" : "+v"(fr), "+v"(fq));
        const int b = u.pm / 33, ks = u.ko / ksub;
        float* dp = part + ((size_t)ks * 512 + (size_t)b * 256) * DM;
        const int col0 = u.pn * BM + wc * 32 + 8 * fq;
#pragma unroll
        for (int ai = 0; ai < 2; ++ai)
#pragma unroll
            for (int m = 0; m < 4; ++m) { float* q = dp + (size_t)(ai * HALF + wr * 64 + m * 16 + fr) * DM + col0;
#pragma unroll
                for (int bj = 0; bj < 2; ++bj) { *(f32x4*)(q + bj * HALF) = acc[ai][bj][m][0]; *(f32x4*)(q + bj * HALF + 4) = acc[ai][bj][m][1]; } }
    }
};
struct EpiDft1 {
    static constexpr bool PERM = false;
    bf16_t* B2t;
    DI void operator()(const f32x4 (&acc)[2][2][4][2], const Unit& u, int wr, int wc, int fr_, int fq_) const {
        int fr = fr_, fq = fq_; asm volatile("" : "+v"(fr), "+v"(fq));
#pragma unroll
        for (int m = 0; m < 4; ++m) { const int c = wr * 64 + m * 16 + fr;
#pragma unroll
            for (int bj = 0; bj < 2; ++bj)
#pragma unroll
                for (int n = 0; n < 2; ++n) { const int nl = bj * HALF + wc * 32 + n * 16 + 4 * fq; const int colg = u.pn * 4 + (nl >> 6), b0 = nl & 63;
                    const f32x4 ar = acc[0][bj][m][n], ai = acc[1][bj][m][n]; float xr[4], xi[4];
#pragma unroll
                    for (int j = 0; j < 4; ++j) { const float ph = (float)((b0 + j) * c) * (6.283185307179586f / 8192.f); const float cs = __cosf(ph), sn = __sinf(ph);
                        xr[j] = ar[j] * cs + ai[j] * sn; xi[j] = ai[j] * cs - ar[j] * sn; }
                    bf16_t* q = B2t + ((size_t)c * 1024 + colg) * 128 + b0;
                    u32x2 w; w.x = cvt_pk_bf16(xr[0], xr[1]); w.y = cvt_pk_bf16(xr[2], xr[3]); *(u32x2*)q = w;
                    w.x = cvt_pk_bf16(xi[0], xi[1]); w.y = cvt_pk_bf16(xi[2], xi[3]); *(u32x2*)(q + 64) = w; } }
    }
};
struct EpiDft2 {
    static constexpr bool PERM = true;
    bf16_t* PQ;
    DI void operator()(const f32x4 (&acc)[2][2][4][2], const Unit& u, int wr, int wc, int fr_, int fq_) const {
        int fr = fr_, fq = fq_; asm volatile("" : "+v"(fr), "+v"(fq));
        const int c = u.pn >> 2;
#pragma unroll
        for (int m = 0; m < 4; ++m) { const int d = m * 16 + fr;
#pragma unroll
            for (int bj = 0; bj < 2; ++bj) { const int colg = (u.pn & 3) * BM + bj * HALF + wc * 32 + 8 * fq; const int batch = colg >> 9, ch = colg & 511;
                const f32x4 v0 = acc[0][bj][m][0], v1 = acc[0][bj][m][1];
                u32x4 w; w.x = cvt_pk_bf16(v0[0], v0[1]); w.y = cvt_pk_bf16(v0[2], v0[3]); w.z = cvt_pk_bf16(v1[0], v1[1]); w.w = cvt_pk_bf16(v1[2], v1[3]);
                *(u32x4*)(PQ + ((size_t)batch * TPB + CTXL + c + 128 * d) * 1024 + wr * 512 + ch) = w; } }
    }
};
struct EpiDftCtx {
    static constexpr bool PERM = false;
    bf16_t* PQ;
    DI void operator()(const f32x4 (&acc)[2][2][4][2], const Unit& u, int wr, int wc, int fr_, int fq_) const {
        int fr = fr_, fq = fq_; asm volatile("" : "+v"(fr), "+v"(fq));
        const int b = u.pn >> 1; const int colt = (u.pn & 1) * BM + wc * 32 + 4 * fq;
        bf16_t* base = PQ + (size_t)b * TPB * 1024 + (u.pm ? 512 : 0);
#pragma unroll
        for (int ai = 0; ai < 2; ++ai)
#pragma unroll
            for (int m = 0; m < 4; ++m) { const int k1 = ai * HALF + wr * 64 + m * 16 + fr;
#pragma unroll
                for (int bj = 0; bj < 2; ++bj)
#pragma unroll
                    for (int n = 0; n < 2; ++n) { const int c = colt + bj * HALF + n * 16; const f32x4 v = acc[ai][bj][m][n];
                        u32x2 w; w.x = cvt_pk_bf16(v[0], v[1]); w.y = cvt_pk_bf16(v[2], v[3]);
                        *(u32x2*)(base + (size_t)k1 * 1024 + c) = w; } }
    }
};
}

namespace att {
constexpr int QP = 272, VP = 144;
constexpr int Q_OFF = 0, K_OFF = 256 * QP  , K_BYTES = 64 * QP  , V_OFF = K_OFF + 2 * K_BYTES  , V_BYTES = 128 * VP  ;
static_assert(V_OFF + 3 * V_BYTES <= LDS_BYTES - 16, "attention LDS (3 V buffers)");
#define MFMA32(a, b, c) __builtin_amdgcn_mfma_f32_32x32x16_bf16((a), (b), (c), 0, 0, 0)
DI bf16x8 pack8(float a0, float a1, float a2, float a3, float a4, float a5, float a6, float a7) {
    u32x4 p;
    asm volatile("v_cvt_pk_bf16_f32 %0, %4, %5\n\tv_cvt_pk_bf16_f32 %1, %6, %7\n\tv_cvt_pk_bf16_f32 %2, %8, %9\n\tv_cvt_pk_bf16_f32 %3, %10, %11\n\ts_nop 1"
                 : "=&v"(p[0]), "=&v"(p[1]), "=&v"(p[2]), "=&v"(p[3])
                 : "v"(a0), "v"(a1), "v"(a2), "v"(a3), "v"(a4), "v"(a5), "v"(a6), "v"(a7));
    return __builtin_bit_cast(bf16x8, p);
}
template <bool SHIFT> DI void attn_unit(LAS unsigned char* lds, const bf16_t* Qb, const bf16_t* Kb, const bf16_t* Vt, bf16_t* concat,
                  int b, int h, int qt, float shift2, float lam, int lam_init_bits, const float* subln_g) {
    const int tid = TID(), wid = __builtin_amdgcn_readfirstlane(tid >> 6), lane = tid & 63, r = lane & 31, hh = lane >> 5;
    const size_t rowbase = (size_t)b * TPB;
    const int q0 = qt * 256;
    const int nkt = (qt == 0) ? 4 : NCH;
    const bf16_t* kg = Kb + rowbase * 1024 + h * 128;
    const bf16_t* vg = Vt + ((size_t)(b * 8 + h) * 128) * TPB;
    const int krow0 = tid >> 4, kc = tid & 15;
    const int vrow0 = tid >> 3, vc = tid & 7;
#pragma unroll
    for (int i = 0; i < 8; ++i) { const int id = i * 512 + tid, row = id >> 4, c = id & 15;
        const u32x4 v = *(const u32x4*)(Qb + (rowbase + q0 + row) * 1024 + h * 128 + c * 8);
        *(LAS u32x4*)(lds + Q_OFF + row * QP + c * 16) = v; }
    u32x4 sg0, sg1;
    sg0 = *(const u32x4*)(kg + (size_t)(krow0) * 1024 + kc * 8); sg1 = *(const u32x4*)(kg + (size_t)(krow0 + 32) * 1024 + kc * 8);
    *(LAS u32x4*)(lds + K_OFF + krow0 * QP + kc * 16) = sg0; *(LAS u32x4*)(lds + K_OFF + (krow0 + 32) * QP + kc * 16) = sg1;
    sg0 = *(const u32x4*)(vg + (size_t)(vrow0) * TPB + vc * 8); sg1 = *(const u32x4*)(vg + (size_t)(vrow0 + 64) * TPB + vc * 8);
    *(LAS u32x4*)(lds + V_OFF + vrow0 * VP + vc * 16) = sg0; *(LAS u32x4*)(lds + V_OFF + (vrow0 + 64) * VP + vc * 16) = sg1;
    if (nkt > 1) { sg0 = *(const u32x4*)(kg + (size_t)(64 + krow0) * 1024 + kc * 8); sg1 = *(const u32x4*)(kg + (size_t)(64 + krow0 + 32) * 1024 + kc * 8); }
    __syncthreads();
    f32x16 OT[2][4];
#pragma unroll
    for (int m = 0; m < 2; ++m)
#pragma unroll
        for (int t = 0; t < 4; ++t)
#pragma unroll
            for (int i = 0; i < 16; ++i) OT[m][t][i] = 0.f;
    float lsum[2] = {0.f, 0.f};
    const LAS unsigned char* qrow = lds + Q_OFF + (32 * wid + r) * QP + hh * 16;
#define SB0() __builtin_amdgcn_sched_barrier(0)
#define QKEXP(P_, half_) do { _Pragma("unroll") for (int m = 0; m < 2; ++m) { \
        f32x16 st; _Pragma("unroll") for (int i = 0; i < 16; ++i) st[i] = 0.f; \
        bf16x8 fq, fk; \
        fq = *(const LAS bf16x8*)(qrow + m * 128); fk = *(const LAS bf16x8*)(kb + (half_) * 32 * QP + m * 128); \
        _Pragma("unroll") for (int s = 0; s < 4; ++s) { \
            SB0(); st = MFMA32(fk, fq, st); SB0(); \
            if (s < 3) { fq = *(const LAS bf16x8*)(qrow + m * 128 + (s + 1) * 32); fk = *(const LAS bf16x8*)(kb + (half_) * 32 * QP + m * 128 + (s + 1) * 32); } } \
        float ls = 0.f; \
        _Pragma("unroll") for (int g_ = 0; g_ < 2; ++g_) { float e_[8]; _Pragma("unroll") for (int i_ = 0; i_ < 8; ++i_) { e_[i_] = __builtin_amdgcn_exp2f(SHIFT ? st[8 * g_ + i_] - shift2 : st[8 * g_ + i_]); ls += e_[i_]; } \
            P_[m][g_] = pack8(e_[0], e_[1], e_[2], e_[3], e_[4], e_[5], e_[6], e_[7]); } \
        lsum[m] += ls; } } while (0)
#define PVH(P_, vptr_) do { bf16x8 fv; fv = *(const LAS bf16x8*)(vptr_); \
        _Pragma("unroll") for (int it = 0; it < 8; ++it) { const int mt = it & 3, sI = it >> 2; \
            SB0(); OT[0][mt] = MFMA32(fv, P_[0][sI], OT[0][mt]); OT[1][mt] = MFMA32(fv, P_[1][sI], OT[1][mt]); SB0(); \
            if (it < 7) { const int mt2 = (it + 1) & 3, s2 = (it + 1) >> 2; fv = *(const LAS bf16x8*)((vptr_) + mt2 * 32 * VP + s2 * 32); } } } while (0)
    const bool lag = wid >= 4;
    bf16x8 Pc[2][2];
#pragma unroll
    for (int m = 0; m < 2; ++m)
#pragma unroll
        for (int g = 0; g < 2; ++g) { u32x4 z = {0u, 0u, 0u, 0u}; Pc[m][g] = __builtin_bit_cast(bf16x8, z); }
    const LAS unsigned char* vold = lds + V_OFF + r * VP + hh * 16;
    int vcur = 0;
    for (int kt = 0; kt < nkt; ++kt) {
        const int cur = kt & 1, nx = cur ^ 1;
        const int vnx = vcur == 2 ? 0 : vcur + 1;
        const bool pf = (kt + 1 < nkt);
        const size_t ko = (size_t)(kt + 1) * 64;
        if (pf) { *(LAS u32x4*)(lds + K_OFF + nx * K_BYTES + krow0 * QP + kc * 16) = sg0; *(LAS u32x4*)(lds + K_OFF + nx * K_BYTES + (krow0 + 32) * QP + kc * 16) = sg1;
            sg0 = *(const u32x4*)(vg + (size_t)(vrow0) * TPB + ko + vc * 8); sg1 = *(const u32x4*)(vg + (size_t)(vrow0 + 64) * TPB + ko + vc * 8); }
        const LAS unsigned char* kb = lds + K_OFF + cur * K_BYTES + r * QP + hh * 16;
        const LAS unsigned char* vb = lds + V_OFF + vcur * V_BYTES + r * VP + hh * 16;
#pragma unroll
        for (int half = 0; half < 2; ++half) {
            if (lag) PVH(Pc, vold);
            QKEXP(Pc, half);
            if (half == 0 && pf) { *(LAS u32x4*)(lds + V_OFF + vnx * V_BYTES + vrow0 * VP + vc * 16) = sg0; *(LAS u32x4*)(lds + V_OFF + vnx * V_BYTES + (vrow0 + 64) * VP + vc * 16) = sg1;
                if (kt + 2 < nkt) { sg0 = *(const u32x4*)(kg + (ko + 64 + krow0) * 1024 + kc * 8); sg1 = *(const u32x4*)(kg + (ko + 64 + krow0 + 32) * 1024 + kc * 8); } }
            vold = vb + half * 64;
            SB0();
            if (!lag) PVH(Pc, vold);
        }
        __syncthreads();
        vcur = vnx;
    }
    if (lag) PVH(Pc, vold);
#undef QKEXP
#undef PVH
#undef SB0
    const float l0 = lsum[0] + __shfl_xor(lsum[0], 32), l1 = lsum[1] + __shfl_xor(lsum[1], 32);
    const float i0 = 1.f / l0, c1 = lam / l1;
    float ss = 0.f;
#pragma unroll
    for (int mt = 0; mt < 4; ++mt)
#pragma unroll
        for (int i = 0; i < 16; ++i) { const float o = OT[0][mt][i] * i0 - OT[1][mt][i] * c1; OT[0][mt][i] = o; ss += o * o; }
    ss += __shfl_xor(ss, 32);
    int lib = lam_init_bits; asm volatile("" : "+s"(lib));
    const float rs = rsqrtf(ss * (1.f / 128.f) + EPS) * (1.f - __builtin_bit_cast(float, lib));
    LAS unsigned char* stg = lds + Q_OFF + (32 * wid) * QP;
#pragma unroll
    for (int mt = 0; mt < 4; ++mt)
#pragma unroll
        for (int g = 0; g < 4; ++g) { const int dv0 = 32 * mt + 8 * g + 4 * hh; const f32x4 gv = *(const f32x4*)(subln_g + dv0);
            u32x2 w; w.x = pk2(OT[0][mt][4 * g] * rs * gv[0], OT[0][mt][4 * g + 1] * rs * gv[1]); w.y = pk2(OT[0][mt][4 * g + 2] * rs * gv[2], OT[0][mt][4 * g + 3] * rs * gv[3]);
            *(LAS u32x2*)(stg + r * QP + dv0 * 2) = w; }
    LDS_WAIT();
#pragma unroll
    for (int i = 0; i < 8; ++i) { const int id = i * 64 + lane, row = id >> 4, c = id & 15;
        const u32x4 v = *(const LAS u32x4*)(stg + row * QP + c * 16);
        *(u32x4*)(concat + (rowbase + q0 + 32 * wid + row) * DM + h * 128 + c * 8) = v; }
    __syncthreads();
}
}

struct Params { const float* in[20]; float* out; unsigned char* ws; int ph_lo, ph_hi, coop, pad; };
enum { I_X = 0, I_C, I_CTX, I_CCTX, I_WMOD, I_BMOD, I_N1G, I_N2G, I_WIN, I_QG, I_KG, I_LAM, I_SUBLN, I_WUP, I_BUP, I_GLAG, I_WF, I_WOUT, I_WFF1, I_WFF2 };

typedef const __attribute__((address_space(4))) Params* KParamsPtr;
DI KParamsPtr KP() { KParamsPtr q = (KParamsPtr)__builtin_amdgcn_kernarg_segment_ptr(); asm volatile("" : "+s"(q)); return q; }
#define PRM (*KP())

DI void tr_item(const float* W, int ldw, int k0, int srcc0, bf16_t* WT, int K, int dstr0, LAS float* scr, int lane) {
#pragma unroll
    for (int i = 0; i < 32; ++i) { const int kk = 2 * i + (lane >> 5); scr[kk * 33 + (lane & 31)] = srcc0 >= 0 ? W[(size_t)(k0 + kk) * ldw + srcc0 + (lane & 31)] : 0.f; }
    LDS_WAIT();
    const int c = lane & 7;
#pragma unroll
    for (int j = 0; j < 4; ++j) { const int n = (lane >> 3) + 8 * j; const LAS float* s = scr + (8 * c) * 33 + n;
        u32x4 o; o.x = pk2(s[0 * 33], s[1 * 33]); o.y = pk2(s[2 * 33], s[3 * 33]); o.z = pk2(s[4 * 33], s[5 * 33]); o.w = pk2(s[6 * 33], s[7 * 33]);
        *(u32x4*)(WT + (size_t)(dstr0 + n) * K + k0 + 8 * c) = o; }
    LDS_WAIT();
}
DI int win_src_col(int n0) {
    if (n0 < 3072 + 1536) return n0;
    if (n0 < 3072 + 2048) return 4640 + (n0 - 4608);
    if (n0 < 3072 + 2080) return 4608 + (n0 - 5120);
    return -1;
}

DI void phase_prep(LAS unsigned char* lds, int l) {
    const int tid = TID(), wid = tid >> 6, lane = tid & 63, G = GDIM(), bx = BID();
    unsigned char* ws = LP(PRM.ws);
    LAS float* tab = (LAS float*)lds;
    for (int m = tid; m < 8192; m += 512) tab[m] = __cosf((float)m * (6.283185307179586f / 8192.f));
    __syncthreads();
    {
        bf16_t* A1 = (bf16_t*)(ws + WS_A1); bf16_t* A2 = (bf16_t*)(ws + WS_A2);
        for (int idx = bx * 512 + tid; idx < 2 * 256 * 128; idx += G * 512) {
            const int which = idx >> 15, m = (idx >> 7) & 255, k = idx & 127; float v;
            if (which == 0) { const int c = m & 127; const float cs = tab[(unsigned)(k * c * 64) & 8191u], sn = tab[((unsigned)(k * c * 64) + 8192u - 2048u) & 8191u]; v = (m < 128 ? cs : -sn) * (1.f / 1024.f); A1[m * 128 + k] = (bf16_t)f2bf(v); }
            else { const int d = m & 63, bb = k & 63; const float cs = tab[(unsigned)(bb * d * 128) & 8191u], sn = tab[((unsigned)(bb * d * 128) + 8192u - 2048u) & 8191u];
                if (m < 64) v = k < 64 ? cs : sn; else if (m < 128) v = k < 64 ? sn : -cs; else v = 0.f;
                A2[m * 128 + k] = (bf16_t)f2bf(v); } }
        if (l == 0) {
            bf16_t* Tc = (bf16_t*)(ws + WS_TCTX);
            for (int id = bx * 512 + tid; id < 512 * 32; id += G * 512) {
                const int rr = id >> 5, n0 = (id & 31) * 8; const bool sp = rr >= 256; const unsigned k1 = sp ? rr - 256 : rr; const unsigned sh = sp ? 8192u - 2048u : 0u;
                float v[8];
#pragma unroll
                for (int j = 0; j < 8; ++j) v[j] = tab[(k1 * (unsigned)(n0 + j) * 32u + sh) & 8191u] * 0.005524271728019903f;
                u32x4 o; o.x = pk2(v[0], v[1]); o.y = pk2(v[2], v[3]); o.z = pk2(v[4], v[5]); o.w = pk2(v[6], v[7]);
                *(u32x4*)(Tc + (size_t)id * 8) = o; } }
        const float* wf = PRM.in[I_WF] + (size_t)l * 512 * 512; bf16_t* Wcs = (bf16_t*)(ws + WS_WCS);
        for (int idx = bx * 512 + tid; idx < 512 * 1024; idx += G * 512) {
            const int j = idx & 511, kk = idx >> 9; const bool sp = kk >= 512; const int k2i = kk & 511, g = k2i >> 7, n2 = k2i & 127; const unsigned sh = sp ? 8192u - 2048u : 0u;
            float acc = 0.f;
            for (int k2 = 0; k2 < 128; ++k2) acc += tab[((unsigned)((k2 * n2) & 127) * 64u + sh) & 8191u] * wf[(size_t)(g * 128 + k2) * 512 + j];
            Wcs[(size_t)j * 1024 + kk] = (bf16_t)f2bf(sp ? -acc : acc); }
    }
    {
        LAS float* scr = (LAS float*)(lds + 32768 + wid * 8448);
        const int gw = bx * 8 + wid, NGW = G * 8;
        constexpr int I_IN = 32 * (NIN / 32), I_OUT = 32 * 64, I_F1 = 32 * 256, I_F2 = 128 * 64;
        const float* win = PRM.in[I_WIN] + (size_t)l * DM * DIN; const float* wout = PRM.in[I_WOUT] + (size_t)l * DM * DM;
        const float* wf1 = PRM.in[I_WFF1] + (size_t)l * DM * DFF; const float* wf2 = PRM.in[I_WFF2] + (size_t)l * DFF * DM;
        for (int it = gw; it < I_IN + I_OUT + I_F1 + I_F2; it += NGW) {
            int r = it;
            if (r < I_IN) { const int nb = r % (NIN / 32), kb = r / (NIN / 32); tr_item(win, DIN, kb * 64, win_src_col(nb * 32), (bf16_t*)(ws + WS_WIN), DM, nb * 32, scr, lane); continue; } r -= I_IN;
            if (r < I_OUT) { const int nb = r % 64, kb = r / 64; tr_item(wout, DM, kb * 64, nb * 32, (bf16_t*)(ws + WS_WOUT), DM, nb * 32, scr, lane); continue; } r -= I_OUT;
            if (r < I_F1) { const int nb = r % 256, kb = r / 256; tr_item(wf1, DFF, kb * 64, nb * 32, (bf16_t*)(ws + WS_WFF1), DM, nb * 32, scr, lane); continue; } r -= I_F1;
            { const int nb = r % 64, kb = r / 64; tr_item(wf2, DM, kb * 64, nb * 32, (bf16_t*)(ws + WS_WFF2), DFF, nb * 32, scr, lane); }
        }
    }
    __syncthreads();
    if (l == 0) {
        LAS float* sv = (LAS float*)lds;
        LAS float* red = (LAS float*)(lds + 24576);
        for (int i = tid; i < 3 * 2048; i += 512) { const int s = i >> 11, k = i & 2047; const float c = s < 2 ? PRM.in[I_C][s * 2048 + k] : PRM.in[I_CCTX][k]; sv[i] = c / (1.f + __expf(-c)); }
        __syncthreads();
        float* mod = (float*)(ws + WS_MOD);
        const int cl = tid & 15, ks = tid >> 4;
        for (int item = bx; item < 2 * 192; item += G) {
            const int l2 = item / 192, j0 = (item % 192) * 64;
            const float* wm = PRM.in[I_WMOD] + ((size_t)l2 * 2048 + ks * 64) * 12288 + j0 + cl * 4;
            f32x4 a0 = {0.f, 0.f, 0.f, 0.f}, a1 = a0, a2 = a0;
#pragma unroll 8
            for (int kk = 0; kk < 64; ++kk) { const f32x4 w = *(const f32x4*)(wm + (size_t)kk * 12288); const int k = ks * 64 + kk;
                a0 += w * sv[k]; a1 += w * sv[2048 + k]; a2 += w * sv[4096 + k]; }
#pragma unroll
            for (int i = 0; i < 4; ++i) { red[(ks * 3 + 0) * 64 + cl * 4 + i] = a0[i]; red[(ks * 3 + 1) * 64 + cl * 4 + i] = a1[i]; red[(ks * 3 + 2) * 64 + cl * 4 + i] = a2[i]; }
            __syncthreads();
            if (tid < 192) { const int s = tid >> 6, ci = tid & 63; float t = PRM.in[I_BMOD][(size_t)l2 * 12288 + j0 + ci];
                for (int k2 = 0; k2 < 32; ++k2) t += red[(k2 * 3 + s) * 64 + ci];
                mod[((size_t)l2 * 3 + s) * 12288 + j0 + ci] = t; }
            __syncthreads();
        }
    }
}

DI const float* hrow_in(int l, int b, int t) {
    if (l == 0) return t < CTXL ? PRM.in[I_CTX] + ((size_t)b * CTXL + t) * DM : PRM.in[I_X] + ((size_t)b * SEQ + (t - CTXL)) * DM;
    return t < CTXL ? (const float*)(LP(PRM.ws) + WS_XC) + ((size_t)b * CTXL + t) * DM : PRM.out + ((size_t)b * SEQ + (t - CTXL)) * DM;
}
DI void phase_norm(int l, int stage, bool skipctx, int fold, int gate_l, int gate_chunk, const void* latsrc, int lat_bf16) {
    const int tid = TID(), wid = tid >> 6, lane = tid & 63;
    const float* mod = (const float*)(LP(PRM.ws) + WS_MOD); bf16_t* A = (bf16_t*)(LP(PRM.ws) + WS_A);
    const float* gvec = PRM.in[stage == 0 ? I_N1G : I_N2G] + (size_t)l * DM;
    f32x4 ggv[8], shv[8]; int cur_s = -1;
    for (int row = BID() * 8 + wid; row < MROWS; row += GDIM() * 8) {
        const int b = row / TPB, t = row % TPB; const bool isctx = t < CTXL;
        if (skipctx && isctx) continue;
        const int ssel = isctx ? 2 : b;
        if (ssel != cur_s) { cur_s = ssel;
            const float* sh = mod + ((size_t)l * 3 + ssel) * 12288 + (size_t)(stage * 3) * DM; const float* sc = sh + DM;
#pragma unroll
            for (int j = 0; j < 8; ++j) { const int c = 4 * (64 * j + lane); ggv[j] = *(const f32x4*)(gvec + c) * (*(const f32x4*)(sc + c) + 1.f); shv[j] = *(const f32x4*)(sh + c); } }
        const float* src = hrow_in(stage == 0 ? l : 1, b, t);
        if (isctx && fold == 1) src = PRM.in[I_CTX] + ((size_t)b * CTXL + t) * DM;
        f32x4 v[8]; float ss = 0.f;
        if (!isctx && lat_bf16) { const bf16_t* sb_ = (const bf16_t*)latsrc + ((size_t)b * SEQ + (t - CTXL)) * DM;
#pragma unroll
            for (int j = 0; j < 8; ++j) { const u32x2 w = *((const u32x2*)sb_ + 64 * j + lane); v[j] = (f32x4){bf2f(w.x & 0xffff), bf2f(w.x >> 16), bf2f(w.y & 0xffff), bf2f(w.y >> 16)}; } }
        else { if (!isctx) src = (const float*)latsrc + ((size_t)b * SEQ + (t - CTXL)) * DM;
#pragma unroll
            for (int j = 0; j < 8; ++j) v[j] = *((const f32x4*)src + 64 * j + lane); }
        if (isctx && fold) {
            const float* part = (const float*)(LP(PRM.ws) + WS_PART) + ((size_t)b * CTXL + t) * DM; const float* gt = mod + ((size_t)gate_l * 3 + 2) * 12288 + (size_t)gate_chunk * DM;
            float* xc = (float*)(LP(PRM.ws) + WS_XC) + ((size_t)b * CTXL + t) * DM;
#pragma unroll
            for (int j = 0; j < 8; ++j) { f32x4 a = *((const f32x4*)part + 64 * j + lane);
#pragma unroll
                for (int k = 1; k < NSPLIT; ++k) a += *((const f32x4*)(part + (size_t)k * 512 * DM) + 64 * j + lane);
                v[j] += a * *((const f32x4*)gt + 64 * j + lane); *((f32x4*)xc + 64 * j + lane) = v[j]; }
        }
#pragma unroll
        for (int j = 0; j < 8; ++j) ss += (v[j][0] * v[j][0] + v[j][1] * v[j][1]) + (v[j][2] * v[j][2] + v[j][3] * v[j][3]);
        const float rs = rsqrtf(wave_sum(ss) * (1.f / DM) + EPS);
#pragma unroll
        for (int j = 0; j < 8; ++j) { const int c = 4 * (64 * j + lane);
            const f32x4 y = v[j] * rs * ggv[j] + shv[j];
            u32x2 w; w.x = pk2(y[0], y[1]); w.y = pk2(y[2], y[3]); *(u32x2*)(A + (size_t)row * DM + c) = w; }
    }
}

DI void tr_unit(LAS unsigned char* lds, const bf16_t* src, int ld, bf16_t* dst, size_t dpitch, bool perm) {
    const int tid = TID();
#pragma unroll
    for (int i = 0; i < 2; ++i) { const int id = i * 512 + tid, row = id >> 4, c = id & 15;
        *(LAS u32x4*)(lds + row * 272 + c * 16) = *(const u32x4*)(src + (size_t)row * ld + c * 8); }
    __syncthreads();
#pragma unroll
    for (int i = 0; i < 2; ++i) { const int id = i * 512 + tid, j = id >> 3, c = id & 7; unsigned e[8];
#pragma unroll
        for (int q = 0; q < 8; ++q) { const int key = perm ? (16 * (c >> 1) + 8 * (q >> 2) + 4 * (c & 1) + (q & 3)) : (8 * c + q); e[q] = *(const LAS unsigned short*)(lds + key * 272 + j * 2); }
        u32x4 o; o.x = e[0] | (e[1] << 16); o.y = e[2] | (e[3] << 16); o.z = e[4] | (e[5] << 16); o.w = e[6] | (e[7] << 16);
        *(u32x4*)(dst + (size_t)j * dpitch + c * 8) = o; }
    __syncthreads();
}

DI void gla_load(LAS unsigned char* lds, int l, int b, int h, int c, int off_q  , int off_k, int off_v, int off_pa, int off_wup, int off_bup) {
    const int tid = TID();
    const bf16_t* P2 = (const bf16_t*)(LP(PRM.ws) + WS_P2) + ((size_t)b * TPB + (size_t)c * 64) * P2W;
    { const int row = tid >> 3, c8 = tid & 7;
      const u32x4 kv = *(const u32x4*)(P2 + (size_t)row * P2W + 256 + h * 64 + c8 * 8); LAS float* kd = (LAS float*)(lds + off_k) + row * 64 + c8 * 8;
      kd[0] = bf2f(kv.x & 0xffff); kd[1] = bf2f(kv.x >> 16); kd[2] = bf2f(kv.y & 0xffff); kd[3] = bf2f(kv.y >> 16); kd[4] = bf2f(kv.z & 0xffff); kd[5] = bf2f(kv.z >> 16); kd[6] = bf2f(kv.w & 0xffff); kd[7] = bf2f(kv.w >> 16);
      if (off_q >= 0) { const u32x4 qv = *(const u32x4*)(P2 + (size_t)row * P2W + h * 64 + c8 * 8); LAS float* qd = (LAS float*)(lds + off_q) + row * 64 + c8 * 8;
        qd[0] = bf2f(qv.x & 0xffff); qd[1] = bf2f(qv.x >> 16); qd[2] = bf2f(qv.y & 0xffff); qd[3] = bf2f(qv.y >> 16); qd[4] = bf2f(qv.z & 0xffff); qd[5] = bf2f(qv.z >> 16); qd[6] = bf2f(qv.w & 0xffff); qd[7] = bf2f(qv.w >> 16); } }
#pragma unroll
    for (int i = 0; i < 2; ++i) { const int id = i * 512 + tid, row = id >> 4, c8 = id & 15;
        const u32x4 vv = *(const u32x4*)(P2 + (size_t)row * P2W + 512 + h * 128 + c8 * 8); LAS float* vd = (LAS float*)(lds + off_v) + row * 128 + c8 * 8;
        vd[0] = bf2f(vv.x & 0xffff); vd[1] = bf2f(vv.x >> 16); vd[2] = bf2f(vv.y & 0xffff); vd[3] = bf2f(vv.y >> 16); vd[4] = bf2f(vv.z & 0xffff); vd[5] = bf2f(vv.z >> 16); vd[6] = bf2f(vv.w & 0xffff); vd[7] = bf2f(vv.w >> 16); }
    if (tid < 256) { const int row = tid >> 2, c8 = tid & 3;
        const u32x4 pv = *(const u32x4*)(P2 + (size_t)row * P2W + 2048 + c8 * 8); LAS float* pd = (LAS float*)(lds + off_pa) + row * 32 + c8 * 8;
        pd[0] = bf2f(pv.x & 0xffff); pd[1] = bf2f(pv.x >> 16); pd[2] = bf2f(pv.y & 0xffff); pd[3] = bf2f(pv.y >> 16); pd[4] = bf2f(pv.z & 0xffff); pd[5] = bf2f(pv.z >> 16); pd[6] = bf2f(pv.w & 0xffff); pd[7] = bf2f(pv.w >> 16); }
#pragma unroll
    for (int i = 0; i < 4; ++i) { const int idx = tid * 4 + i, d = idx >> 10, rr = (idx >> 6) & 15, dk = idx & 63;
        ((LAS float*)(lds + off_wup))[idx] = PRM.in[I_WUP][((size_t)(l * 2 + d) * 16 + rr) * 256 + h * 64 + dk]; }
    if (tid < 128) { const int d = tid >> 6, dk = tid & 63; ((LAS float*)(lds + off_bup))[tid] = PRM.in[I_BUP][(size_t)(l * 2 + d) * 256 + h * 64 + dk]; }
}
DI float gla_cumsum(const LAS float* paf, const LAS float* wup, const LAS float* bup, int d, int dk, LAS float* out) {
    float w[16];
#pragma unroll
    for (int rr = 0; rr < 16; ++rr) w[rr] = wup[(d * 16 + rr) * 64 + dk];
    const float bb = bup[d * 64 + dk];
    float run = 0.f;
    for (int s = 0; s < 64; ++s) { const int t = d ? 63 - s : s; float z = bb;
#pragma unroll
        for (int rr = 0; rr < 16; ++rr) z += paf[t * 32 + d * 16 + rr] * w[rr];
        run += logsig(z) * (1.f / 16.f); out[t * 64 + dk] = run; }
    return run;
}
DI float gla_cumsum_par(LAS float* buf, LAS float* seg, int tid) {
    const int col = tid & 127, d = col >> 6, dk = col & 63, sg = tid >> 7;
    LAS float* p = buf + d * 4096 + dk;
    float v[16]; float run = 0.f;
#pragma unroll
    for (int i = 0; i < 16; ++i) { const int sp = sg * 16 + i, t = d ? 63 - sp : sp; run += p[t * 64]; v[i] = run; }
    seg[sg * 128 + col] = run;
    __syncthreads();
    const float s0 = seg[col], s1 = seg[128 + col], s2 = seg[256 + col], s3 = seg[384 + col];
    const float pre = sg == 0 ? 0.f : sg == 1 ? s0 : sg == 2 ? s0 + s1 : s0 + s1 + s2;
#pragma unroll
    for (int i = 0; i < 16; ++i) { const int sp = sg * 16 + i, t = d ? 63 - sp : sp; p[t * 64] = v[i] + pre; }
    return (s0 + s1) + (s2 + s3);
}
DI void gla_g1_unit(LAS unsigned char* lds, int l, int b, int h, int c) {
    constexpr int OK = 0, OV = 16384, OPA = 49152, OWUP = 57344, OBUP = 65536, OE = 66560;
    const int tid = TID();
    gla_load(lds, l, b, h, c, -1, OK, OV, OPA, OWUP, OBUP);
    __syncthreads();
    const LAS float* kf = (const LAS float*)(lds + OK); const LAS float* vf = (const LAS float*)(lds + OV);
    LAS float* E = (LAS float*)(lds + OE);
    bf16_t* KV = (bf16_t*)(LP(PRM.ws) + WS_KV); float* DEC = (float*)(LP(PRM.ws) + WS_DEC);
    {
        const LAS float* paf = (const LAS float*)(lds + OPA); const LAS float* wup = (const LAS float*)(lds + OWUP); const LAS float* bup = (const LAS float*)(lds + OBUP);
        LAS float* bl_s = (LAS float*)(lds + OE + 32768);
        const int dk = tid & 63;
#pragma unroll
        for (int d = 0; d < 2; ++d) { float w[16];
#pragma unroll
            for (int rr = 0; rr < 16; ++rr) w[rr] = wup[(d * 16 + rr) * 64 + dk];
            const float bb = bup[d * 64 + dk];
            for (int t = tid >> 6; t < 64; t += 8) { float z = bb;
#pragma unroll
                for (int rr = 0; rr < 16; ++rr) z += paf[t * 32 + d * 16 + rr] * w[rr];
                E[d * 4096 + t * 64 + dk] = logsig(z) * (1.f / 16.f); } }
        __syncthreads();
        { const float tot = gla_cumsum_par(E, (LAS float*)(lds + OE + 32768 + 512), tid);
          if (tid < 128) { const int d = tid >> 6; bl_s[d * 64 + dk] = tot; DEC[((size_t)((b * 2 + d) * 4 + h) * NCH + c) * 64 + dk] = __expf(tot); } }
        __syncthreads();
#pragma unroll
        for (int i = 0; i < 16; ++i) { const int idx = i * 512 + tid, d = idx >> 12, td = idx & 4095; E[idx] = __expf(bl_s[d * 64 + (td & 63)] - E[idx]) * kf[td]; }
    }
    __syncthreads();
    { const int d = tid >> 8, tt = tid & 255, dvq = tt & 31, dkq = tt >> 5; const LAS float* Ed = E + d * 4096;
      f32x4 acc[8];
#pragma unroll
      for (int i = 0; i < 8; ++i) acc[i] = (f32x4){0.f, 0.f, 0.f, 0.f};
      for (int t = 0; t < 64; ++t) { const f32x4 vv = *(const LAS f32x4*)(vf + t * 128 + 4 * dvq);
#pragma unroll
          for (int i = 0; i < 8; ++i) acc[i] += vv * Ed[t * 64 + dkq * 8 + i]; }
      bf16_t* dst = KV + ((size_t)((b * 2 + d) * 4 + h) * NCH + c) * 8192;
#pragma unroll
      for (int i = 0; i < 8; ++i) { u32x2 w; w.x = pk2(acc[i][0], acc[i][1]); w.y = pk2(acc[i][2], acc[i][3]); *(u32x2*)(dst + (dkq * 8 + i) * 128 + 4 * dvq) = w; } }
    __syncthreads();
}
DI void gla_scan() {
    const int tid = TID(); unsigned* KV = (unsigned*)(LP(PRM.ws) + WS_KV); const float* DEC = (const float*)(LP(PRM.ws) + WS_DEC);
    for (int item = BID(); item < 128; item += GDIM()) {
        const int seq = item >> 3, slab = item & 7, d = (seq >> 2) & 1, e2 = slab * 512 + tid  , dk = e2 >> 6;
        float S0 = 0.f, S1 = 0.f;
        for (int s0 = 0; s0 < NCH; s0 += 33) { unsigned kvv[33]; float dc[33];
#pragma unroll
            for (int j = 0; j < 33; ++j) { const int st = s0 + j, c = d ? (st < 4 ? 3 - st : 135 - st) : st; kvv[j] = KV[((size_t)seq * NCH + c) * 4096 + e2]; dc[j] = DEC[((size_t)seq * NCH + c) * 64 + dk]; }
#pragma unroll
            for (int j = 0; j < 33; ++j) { const int st = s0 + j, c = d ? (st < 4 ? 3 - st : 135 - st) : st; KV[((size_t)seq * NCH + c) * 4096 + e2] = pk2(S0, S1);
                S0 = dc[j] * S0 + bf2f(kvv[j] & 0xffff); S1 = dc[j] * S1 + bf2f(kvv[j] >> 16); } }
    }
}
DI void gla_g3_unit(LAS unsigned char* lds, int l, int b, int h, int c) {
    constexpr int OQ = 0, OK = 16384, OPA = 32768, OWUP = 40960, OBUP = 49152, OG = 50176, OVT = 82944, OQE = 101376, OKE = 110592, OST = 119808, OOT = 0, PB = 144;
    const int tid = TID(), wid = __builtin_amdgcn_readfirstlane(tid >> 6), lane = tid & 63, r = lane & 31, hh = lane >> 5;
    const bf16_t* P2 = (const bf16_t*)(LP(PRM.ws) + WS_P2) + ((size_t)b * TPB + (size_t)c * 64) * P2W;
    {
        const int row = tid >> 3, c8 = tid & 7;
        const u32x4 kv = *(const u32x4*)(P2 + (size_t)row * P2W + 256 + h * 64 + c8 * 8); LAS float* kd = (LAS float*)(lds + OK) + row * 64 + c8 * 8;
        kd[0] = bf2f(kv.x & 0xffff); kd[1] = bf2f(kv.x >> 16); kd[2] = bf2f(kv.y & 0xffff); kd[3] = bf2f(kv.y >> 16); kd[4] = bf2f(kv.z & 0xffff); kd[5] = bf2f(kv.z >> 16); kd[6] = bf2f(kv.w & 0xffff); kd[7] = bf2f(kv.w >> 16);
        const u32x4 qv = *(const u32x4*)(P2 + (size_t)row * P2W + h * 64 + c8 * 8); LAS float* qd = (LAS float*)(lds + OQ) + row * 64 + c8 * 8;
        qd[0] = bf2f(qv.x & 0xffff); qd[1] = bf2f(qv.x >> 16); qd[2] = bf2f(qv.y & 0xffff); qd[3] = bf2f(qv.y >> 16); qd[4] = bf2f(qv.z & 0xffff); qd[5] = bf2f(qv.z >> 16); qd[6] = bf2f(qv.w & 0xffff); qd[7] = bf2f(qv.w >> 16);
#pragma unroll
        for (int i = 0; i < 2; ++i) { const int id = i * 512 + tid, m = id >> 4, cc = id & 15;
            const u32x4 vv = *(const u32x4*)(P2 + (size_t)m * P2W + 512 + h * 128 + cc * 8);
            const int m16 = m & 15, pos = (m & ~15) + 8 * ((m16 >> 2) & 1) + ((m16 >> 3) << 2) + (m16 & 3);
            LAS unsigned short* vt = (LAS unsigned short*)(lds + OVT + (cc * 8) * PB + pos * 2);
            vt[0 * (PB / 2)] = vv.x & 0xffff; vt[1 * (PB / 2)] = vv.x >> 16; vt[2 * (PB / 2)] = vv.y & 0xffff; vt[3 * (PB / 2)] = vv.y >> 16;
            vt[4 * (PB / 2)] = vv.z & 0xffff; vt[5 * (PB / 2)] = vv.z >> 16; vt[6 * (PB / 2)] = vv.w & 0xffff; vt[7 * (PB / 2)] = vv.w >> 16; }
        if (tid < 256) { const int prow = tid >> 2, p8 = tid & 3;
            const u32x4 pv = *(const u32x4*)(P2 + (size_t)prow * P2W + 2048 + p8 * 8); LAS float* pd = (LAS float*)(lds + OPA) + prow * 32 + p8 * 8;
            pd[0] = bf2f(pv.x & 0xffff); pd[1] = bf2f(pv.x >> 16); pd[2] = bf2f(pv.y & 0xffff); pd[3] = bf2f(pv.y >> 16); pd[4] = bf2f(pv.z & 0xffff); pd[5] = bf2f(pv.z >> 16); pd[6] = bf2f(pv.w & 0xffff); pd[7] = bf2f(pv.w >> 16); }
#pragma unroll
        for (int i = 0; i < 4; ++i) { const int idx = tid * 4 + i, d = idx >> 10, rr = (idx >> 6) & 15, dk = idx & 63;
            ((LAS float*)(lds + OWUP))[idx] = PRM.in[I_WUP][((size_t)(l * 2 + d) * 16 + rr) * 256 + h * 64 + dk]; }
        if (tid < 128) { const int d = tid >> 6, dk = tid & 63; ((LAS float*)(lds + OBUP))[tid] = PRM.in[I_BUP][(size_t)(l * 2 + d) * 256 + h * 64 + dk]; }
    }
    __syncthreads();
    const LAS float* qf = (const LAS float*)(lds + OQ); const LAS float* kf = (const LAS float*)(lds + OK);
    const LAS float* paf = (const LAS float*)(lds + OPA); const LAS float* wup = (const LAS float*)(lds + OWUP); const LAS float* bup = (const LAS float*)(lds + OBUP);
    LAS float* gl = (LAS float*)(lds + OG);
    {
        const int dk = tid & 63;
#pragma unroll
        for (int d = 0; d < 2; ++d) { float w[16];
#pragma unroll
            for (int rr = 0; rr < 16; ++rr) w[rr] = wup[(d * 16 + rr) * 64 + dk];
            const float bb = bup[d * 64 + dk];
            for (int t = tid >> 6; t < 64; t += 8) { float z = bb;
#pragma unroll
                for (int rr = 0; rr < 16; ++rr) z += paf[t * 32 + d * 16 + rr] * w[rr];
                gl[d * 4096 + t * 64 + dk] = logsig(z) * (1.f / 16.f); } }
    }
    __syncthreads();
    (void)gla_cumsum_par(gl, (LAS float*)(lds + 138240), tid);
    __syncthreads();
    const int mt = wid & 3, ntl = wid >> 2;
    f32x16 acc;
#pragma unroll
    for (int i = 0; i < 16; ++i) acc[i] = 0.f;
    const bf16_t* KV = (const bf16_t*)(LP(PRM.ws) + WS_KV);
    for (int d = 0; d < 2; ++d) {
        {
#pragma unroll
            for (int i = 0; i < 4; ++i) { const int idx2 = (i * 512 + tid) * 2, t = idx2 >> 6, dk = idx2 & 63;
                const float b0 = gl[d * 4096 + idx2], b1 = gl[d * 4096 + idx2 + 1];
                *(LAS unsigned*)(lds + OQE + t * PB + dk * 2) = pk2(qf[idx2] * __expf(b0) * 0.125f, qf[idx2 + 1] * __expf(b1) * 0.125f);
                *(LAS unsigned*)(lds + OKE + t * PB + dk * 2) = pk2(kf[idx2] * __expf(-b0), kf[idx2 + 1] * __expf(-b1)); }
            const bf16_t* Sg = KV + ((size_t)((b * 2 + d) * 4 + h) * NCH + c) * 8192;
#pragma unroll
            for (int i = 0; i < 2; ++i) { const int id = i * 512 + tid, dk = id >> 4, dv8 = (id & 15) * 8; const u32x4 sv = *(const u32x4*)(Sg + dk * 128 + dv8);
                LAS unsigned short* st = (LAS unsigned short*)(lds + OST + dv8 * PB + dk * 2);
                st[0] = sv.x & 0xffff; st[PB / 2] = sv.x >> 16; st[2 * (PB / 2)] = sv.y & 0xffff; st[3 * (PB / 2)] = sv.y >> 16;
                st[4 * (PB / 2)] = sv.z & 0xffff; st[5 * (PB / 2)] = sv.z >> 16; st[6 * (PB / 2)] = sv.w & 0xffff; st[7 * (PB / 2)] = sv.w >> 16; }
        }
        __syncthreads();
        {
            bf16x8 qfr[4];
#pragma unroll
            for (int s = 0; s < 4; ++s) qfr[s] = *(const LAS bf16x8*)(lds + OQE + (32 * ntl + r) * PB + s * 32 + hh * 16);
#pragma unroll
            for (int s = 0; s < 4; ++s) { const bf16x8 sf = *(const LAS bf16x8*)(lds + OST + (32 * mt + r) * PB + s * 32 + hh * 16); acc = MFMA32(sf, qfr[s], acc); }
#pragma unroll
            for (int j = 0; j < 2; ++j) {
                f32x16 at;
#pragma unroll
                for (int i = 0; i < 16; ++i) at[i] = 0.f;
#pragma unroll
                for (int s = 0; s < 4; ++s) { const bf16x8 kfr = *(const LAS bf16x8*)(lds + OKE + (32 * j + r) * PB + s * 32 + hh * 16); at = MFMA32(kfr, qfr[s], at); }
                const int tcol = 32 * ntl + r;
#pragma unroll
                for (int i = 0; i < 16; ++i) { const int m = 32 * j + (i & 3) + 8 * (i >> 2) + 4 * hh; const bool keep = d ? (m >= tcol) : (m <= tcol); at[i] = keep ? at[i] : 0.f; }
#pragma unroll
                for (int s = 0; s < 2; ++s) {
                    const bf16x8 pf = att::pack8(at[8 * s], at[8 * s + 1], at[8 * s + 2], at[8 * s + 3], at[8 * s + 4], at[8 * s + 5], at[8 * s + 6], at[8 * s + 7]);
                    const bf16x8 vfr = *(const LAS bf16x8*)(lds + OVT + (32 * mt + r) * PB + (2 * j + s) * 32 + hh * 16);
                    acc = MFMA32(vfr, pf, acc); }
            }
        }
        __syncthreads();
    }
    {
        LAS float* oT = (LAS float*)(lds + OOT);
        const int t = 32 * ntl + r;
#pragma unroll
        for (int i = 0; i < 16; ++i) { const int dv = 32 * mt + (i & 3) + 8 * (i >> 2) + 4 * hh; oT[t * 132 + dv] = acc[i]; }
    }
    __syncthreads();
    const int tq = tid >> 5, dvq = tid & 31;
    const f32x4 gg = *(const f32x4*)(PRM.in[I_GLAG] + (size_t)l * 128 + 4 * dvq);
    bf16_t* concat = (bf16_t*)(LP(PRM.ws) + WS_A);
#pragma unroll
    for (int i = 0; i < 4; ++i) { const f32x4 o = *(const LAS f32x4*)(lds + OOT + ((4 * tq + i) * 132 + 4 * dvq) * 4);
        float ss = (o[0] * o[0] + o[1] * o[1]) + (o[2] * o[2] + o[3] * o[3]);
#pragma unroll
        for (int s = 1; s < 32; s <<= 1) ss += __shfl_xor(ss, s);
        const float rs = rsqrtf(ss * (1.f / 128.f) + EPS);
        const size_t row = (size_t)c * 64 + 4 * tq + i;
        const u32x2 rv = *(const u32x2*)(P2 + row % 64 * P2W + 1024 + h * 128 + 4 * dvq);
        float r4[4] = {bf2f(rv.x & 0xffff), bf2f(rv.x >> 16), bf2f(rv.y & 0xffff), bf2f(rv.y >> 16)}; float y[4];
#pragma unroll
        for (int j = 0; j < 4; ++j) y[j] = o[j] * rs * gg[j] * (r4[j] / (1.f + __expf(-r4[j])));
        u32x2 w; w.x = pk2(y[0], y[1]); w.y = pk2(y[2], y[3]); *(u32x2*)(concat + ((size_t)b * TPB + row) * DM + 1024 + h * 128 + 4 * dvq) = w; }
    __syncthreads();
}

DI void phase_post(LAS unsigned char* lds, int l, bool do_qk) {
    const int tid = TID(), wid = tid >> 6, lane = tid & 63, G = GDIM(), bx = BID();
    unsigned char* ws = LP(PRM.ws);
    if (do_qk) {
        const int lp = lane & 31, d0 = 2 * lp, dd = d0 & 31, i0 = dd & 15; const bool axis = d0 >= 32; const float sgn = dd < 16 ? -1.f : 1.f;
        const float inv0 = exp2f(-(float)i0 * (13.287712379549449f / 16.f)), inv1 = exp2f(-(float)(i0 + 1) * (13.287712379549449f / 16.f));
        const float gq0 = PRM.in[I_QG][(size_t)l * 64 + d0], gq1 = PRM.in[I_QG][(size_t)l * 64 + d0 + 1], gk0 = PRM.in[I_KG][(size_t)l * 64 + d0], gk1 = PRM.in[I_KG][(size_t)l * 64 + d0 + 1];
        for (int row = bx * 8 + wid; row < MROWS; row += G * 8) {
            const int t = row % TPB; const bool isctx = t < CTXL; const int tl = t - CTXL;
            const float pos = (float)(axis ? (tl & 63) : (tl >> 6));
            float s0 = 0.f, c0 = 1.f, s1 = 0.f, c1 = 1.f;
            if (!isctx) { const float a0 = pos * inv0, a1 = pos * inv1; s0 = __sinf(a0); c0 = __cosf(a0); s1 = __sinf(a1); c1 = __cosf(a1); }
            for (int which = 0; which < 2; ++which) {
                bf16_t* base = (bf16_t*)(ws + (which ? WS_KB : WS_QB)) + (size_t)row * 1024;
                const float g0 = which ? gk0 : gq0, g1 = which ? gk1 : gq1;
                unsigned wv[8];
#pragma unroll
                for (int it = 0; it < 8; ++it) wv[it] = *(const unsigned*)(base + it * 128 + lane * 2);
#pragma unroll
                for (int it = 0; it < 8; ++it) { const unsigned w = wv[it];
                    const float x0 = bf2f(w & 0xffff), x1 = bf2f(w >> 16); float ss = x0 * x0 + x1 * x1;
#pragma unroll
                    for (int s = 1; s < 32; s <<= 1) ss += __shfl_xor(ss, s);
                    const float rs = rsqrtf(ss * (1.f / 64.f) + EPS); float y0 = x0 * rs * g0, y1 = x1 * rs * g1;
                    const float p0 = __shfl_xor(y0, 8), p1 = __shfl_xor(y1, 8);
                    if (!isctx) { y0 = y0 * c0 + sgn * p0 * s0; y1 = y1 * c1 + sgn * p1 * s1; }
                    if (which == 0) { y0 *= QSCALE; y1 *= QSCALE; }
                    wv[it] = pk2(y0, y1); }
#pragma unroll
                for (int it = 0; it < 8; ++it) *(unsigned*)(base + it * 128 + lane * 2) = wv[it];
            }
        }
    }
    for (int u = bx; u < NB * NCH * 8; u += G) { const int h = u & 7, kt = (u >> 3) % NCH, b = u / (8 * NCH);
        tr_unit(lds, (const bf16_t*)(ws + WS_VB) + ((size_t)b * TPB + (size_t)kt * 64) * 1024 + h * 128, 1024,
                (bf16_t*)(ws + WS_VT) + ((size_t)(b * 8 + h) * 128) * TPB + (size_t)kt * 64, TPB, true); }
    for (int u = bx; u < NB * 4 * 4; u += G) { const int cgp = u & 3, kt = (u >> 2) & 3, b = u >> 4;
        const bf16_t* src = (const bf16_t*)(ws + WS_P2) + ((size_t)b * TPB + (size_t)kt * 64) * P2W + 1536 + cgp * 128;
        tr_unit(lds, src, P2W, (bf16_t*)(ws + WS_UTC) + ((size_t)(b * 512 + cgp * 128)) * 256 + kt * 64, 256, false); }
    for (int u = bx; u < NB * 64 * 4; u += G) { const int cgp = u & 3, bb = (u >> 2) & 63, b = u >> 8;
        const bf16_t* src = (const bf16_t*)(ws + WS_P2) + ((size_t)b * TPB + CTXL + bb) * P2W + 1536 + cgp * 128;
        bf16_t* dst = (bf16_t*)(ws + WS_UTL) + ((size_t)(b * 512 + cgp * 128) * 64 + bb) * 128;
#pragma unroll
        for (int i = 0; i < 4; ++i) { const int id = i * 512 + tid, row = id >> 4, c = id & 15;
            *(LAS u32x4*)(lds + row * 272 + c * 16) = *(const u32x4*)(src + (size_t)row * 64 * P2W + c * 8); }
        __syncthreads();
#pragma unroll
        for (int i = 0; i < 4; ++i) { const int id = i * 512 + tid, j = id >> 4, c = id & 15; unsigned e[8];
#pragma unroll
            for (int q = 0; q < 8; ++q) e[q] = *(const LAS unsigned short*)(lds + (8 * c + q) * 272 + j * 2);
            u32x4 o; o.x = e[0] | (e[1] << 16); o.y = e[2] | (e[3] << 16); o.z = e[4] | (e[5] << 16); o.w = e[6] | (e[7] << 16);
            *(u32x4*)(dst + (size_t)j * 8192 + c * 8) = o; }
        __syncthreads(); }
    for (int u = bx; u < NB * 4 * NCH; u += G) { const int c = u % NCH, h = (u / NCH) & 3, b = u / (4 * NCH); gla_g1_unit(lds, l, b, h, c); }
}

#define XB_TMO      128
#define XB_XCNT(j)  (256  + 64 * (j))
#define XB_XSUB(j)  (1280 + 64 * (j))
#define XB_XGEN(j)  (2304 + 64 * (j))
#define XB_TOP      3328
#define XB_TOPGEN   3392
#define XCD_BAR_WORDS 3456
#define XB_SPIN_CAP (1u << 18)
DI unsigned xb_ld(unsigned* p)              { return __hip_atomic_load(p, __ATOMIC_RELAXED, __HIP_MEMORY_SCOPE_AGENT); }
DI unsigned xb_add(unsigned* p, unsigned v) { return __hip_atomic_fetch_add(p, v, __ATOMIC_RELAXED, __HIP_MEMORY_SCOPE_AGENT); }
DI unsigned xb_xcc_id() { return (unsigned)__builtin_amdgcn_s_getreg((3 << 11) | 20) & 0xFu; }
#define XB_SPIN(cond, bar) do { unsigned _sp = 0; while (cond) { __builtin_amdgcn_s_sleep(1); \
    if ((++_sp & 255u) == 0u) { if (xb_ld(&(bar)[XB_TMO])) break; if (_sp > XB_SPIN_CAP) { atomicAdd(&(bar)[XB_TMO], 1u); break; } } } } while (0)
struct XcdBarrier { unsigned* bar; unsigned x; volatile LAS unsigned* st; };
DI void xcd_barrier_post(unsigned* bar) { if (threadIdx.x == 0) (void)xb_add(&bar[XB_XCNT(xb_xcc_id())], 1u); }
DI void xcd_barrier_complete(unsigned* bar, unsigned x, unsigned& nloc, unsigned& nx) {
    const unsigned G = gridDim.x * gridDim.y * gridDim.z;
    unsigned sum, cnt, mine, sp = 0u;
    for (;;) {
        sum = 0u; cnt = 0u; mine = 0u;
#pragma unroll
        for (unsigned j = 0; j < 16; ++j) { const unsigned c = xb_ld(&bar[XB_XCNT(j)]); sum += c; cnt += (c > 0u) ? 1u : 0u; mine = (j == x) ? c : mine; }
        if (sum == G) break;
        __builtin_amdgcn_s_sleep(1);
        if ((++sp & 255u) == 0u) { if (xb_ld(&bar[XB_TMO])) break; if (sp > XB_SPIN_CAP) { atomicAdd(&bar[XB_TMO], 1u); break; } }
    }
    nloc = mine > 0u ? mine : 1u; nx = cnt > 0u ? cnt : 1u;
}
DI void xcd_barrier(const XcdBarrier& b) {
    asm volatile("s_waitcnt vmcnt(0)" ::: "memory");
    __syncthreads();
    if (threadIdx.x == 0) {
        unsigned* bar = b.bar;
        __builtin_amdgcn_s_waitcnt(0);
        unsigned nloc = b.st[0], nx = b.st[1];
        if (nloc == 0u) { xcd_barrier_complete(bar, b.x, nloc, nx); b.st[0] = nloc; b.st[1] = nx; }
        const unsigned old = xb_add(&bar[XB_XSUB(b.x)], 1u);
        const unsigned gen = old / nloc;
        if (old + 1u == (gen + 1u) * nloc) {
            __builtin_amdgcn_fence(__ATOMIC_RELEASE, "agent");
            asm volatile("s_waitcnt vmcnt(0)" ::: "memory");
            const unsigned og = xb_add(&bar[XB_TOP], 1u);
            const unsigned tg = og / nx;
            if (og + 1u == (tg + 1u) * nx) xb_add(&bar[XB_TOPGEN], 1u);
            else XB_SPIN(xb_ld(&bar[XB_TOPGEN]) == tg, bar);
            __builtin_amdgcn_fence(__ATOMIC_ACQUIRE, "agent");
            xb_add(&bar[XB_XGEN(b.x)], 1u);
            asm volatile("s_waitcnt vmcnt(0)" ::: "memory");
        } else {
            XB_SPIN(xb_ld(&bar[XB_XGEN(b.x)]) == gen, bar);
            __builtin_amdgcn_fence(__ATOMIC_ACQUIRE, "agent");
            asm volatile("s_waitcnt vmcnt(0)" ::: "memory");
        }
    }
    __syncthreads();
}

__global__ void __launch_bounds__(512, 2) mega(Params p_unused) {
    extern __shared__ __attribute__((aligned(16))) unsigned char lds_raw[];
    LAS unsigned char* lds = (LAS unsigned char*)lds_raw;
    cg::grid_group grid = cg::this_grid();
    #define RUN(k) (PRM.ph_lo <= (k) && (k) < PRM.ph_hi)
#define SEAM_ALWAYS() do { XcdBarrier xb_{(unsigned*)(LP(PRM.ws) + WS_BAR), xb_xcc_id(), (volatile LAS unsigned*)(lds + LDS_BYTES - 16)}; xcd_barrier(xb_); } while (0)
#define SEAM(k) do { if (PRM.coop && RUN(k) && RUN((k) + 1)) { XcdBarrier xb_{(unsigned*)(LP(PRM.ws) + WS_BAR), xb_xcc_id(), (volatile LAS unsigned*)(lds + LDS_BYTES - 16)}; xcd_barrier(xb_); } } while (0)
    if (PRM.coop == 2) grid.sync();
    { volatile LAS unsigned* stw = (volatile LAS unsigned*)(lds + LDS_BYTES - 16); if (threadIdx.x == 0) { stw[0] = 0u; stw[1] = 0u; } __syncthreads();
      if (PRM.coop) xcd_barrier_post((unsigned*)(LP(PRM.ws) + WS_BAR)); }
#if REPK == 20
    if (PRM.coop) for (int i = 0; i < 20; ++i) SEAM_ALWAYS();
#endif
    for (int l = 0; l < 2; ++l) {
        const int P = l * 10;
        const bool last = (l == 1);
        const float lam_init = 0.8f - 0.6f * __expf(-0.3f * (float)l);
#ifndef NO_PREP
        if (RUN(P + 0)) for (int rep = 0; rep < NREP(0); ++rep) phase_prep(lds, l);
#endif
        if (l == 0) SEAM(P + 0);
        if (RUN(P + 1)) for (int rep = 0; rep < NREP(1); ++rep) phase_norm(l, 0, false, l == 1 ? 2 : 0, 0, 5, l == 0 ? (const void*)PRM.in[I_X] : (const void*)PRM.out, l == 0 ? 0 : 1);
        SEAM(P + 1);
        if (RUN(P + 2)) for (int rep = 0; rep < NREP(2); ++rep) {
            pg8::Gemm g{(const bf16_t*)(LP(PRM.ws) + WS_A), (const bf16_t*)(LP(PRM.ws) + WS_WIN), DM, DM, DM};
            pg8::Order S; S.init(MROWS / 256, NIN / 256, GDIM(), BID(), 0);
            pg8::EpiBf16<0> E{(bf16_t*)(LP(PRM.ws) + WS_QB), 1024, 1};
            pg8::gemm_phase(lds, g, S, E);
        }
        SEAM(P + 2);
#ifndef NO_POST
        if (RUN(P + 3)) for (int rep = 0; rep < NREP(3); ++rep) phase_post(lds, l, rep == 0);
#endif
        SEAM(P + 3);
        if (RUN(P + 4)) {
            gla_scan();
#if REPK == 11
            if (l == 0) { SEAM_ALWAYS(); for (int u = BID(); u < NB * 4 * NCH; u += GDIM()) { const int c = u % NCH, h = (u / NCH) & 3, b = u / (4 * NCH); gla_g1_unit(lds, l, b, h, c); } SEAM_ALWAYS(); gla_scan(); }
#endif
#if REPK == 12
            if (l == 0) { SEAM_ALWAYS(); for (int u = BID(); u < NB * 4 * NCH; u += GDIM()) { const int c = u % NCH, h = (u / NCH) & 3, b = u / (4 * NCH); gla_g1_unit(lds, l, b, h, c); } SEAM_ALWAYS(); }
#endif
            for (int rep = 0; rep < NREP(4); ++rep) {
            {
                pg8::Gemm g{(const bf16_t*)(LP(PRM.ws) + WS_A1), (const bf16_t*)(LP(PRM.ws) + WS_UTL), 128, 128, 128};
                pg8::Order S; S.init(1, 256, GDIM(), BID(), 0);
                pg8::EpiDft1 E{(bf16_t*)(LP(PRM.ws) + WS_B2T)};
                pg8::gemm_phase(lds, g, S, E);
            }
            if (!last) {
                pg8::Gemm g{(const bf16_t*)(LP(PRM.ws) + WS_TCTX), (const bf16_t*)(LP(PRM.ws) + WS_UTC), 256, 256, 256};
                pg8::Order S; S.init(2, 4, 8, BID() - 116, 0);
                pg8::EpiDftCtx E{(bf16_t*)(LP(PRM.ws) + WS_PQ)};
                pg8::gemm_phase(lds, g, S, E);
            }
            __syncthreads();
            if (PRM.coop) SEAM_ALWAYS();
            {
                pg8::Gemm g{(const bf16_t*)(LP(PRM.ws) + WS_A2), (const bf16_t*)(LP(PRM.ws) + WS_B2T), 128, 128, 128};
                pg8::Order S; S.init(1, 512, GDIM(), BID(), 0);
                pg8::EpiDft2 E{(bf16_t*)(LP(PRM.ws) + WS_PQ)};
                pg8::gemm_phase(lds, g, S, E);
            }
            __syncthreads();
#ifndef NO_ATT
            {
                const float* qg = PRM.in[I_QG] + l * 64; const float* kgv = PRM.in[I_KG] + l * 64; const float* lp = PRM.in[I_LAM] + l * 256;
                float mq = 0.f, mk = 0.f, s01 = 0.f, s23 = 0.f;
                for (int i = 0; i < 64; ++i) { mq = fmaxf(mq, fabsf(qg[i])); mk = fmaxf(mk, fabsf(kgv[i])); s01 += lp[i] * lp[64 + i]; s23 += lp[128 + i] * lp[192 + i]; }
                const float shift2 = 8.f * mq * mk * LOG2E * 1.02f;
                const float lam = __builtin_bit_cast(float, __builtin_amdgcn_readfirstlane(__builtin_bit_cast(int, __expf(s01) - __expf(s23) + lam_init)));
                const int lam_init_bits = __builtin_amdgcn_readfirstlane(__builtin_bit_cast(int, lam_init));
                const int nun = last ? 512 : 528;
                const int G = GDIM(), bx = BID(); const int vcu = (G % 8 == 0) ? (bx % 8) * (G / 8) + bx / 8 : bx;
                for (int u = vcu; u < nun; u += G) {
                    int b, h, qt;
                    if (u < 512) { b = u >> 8; h = (u >> 5) & 7; qt = (u & 31) + 1; } else { const int v = u - 512; b = v >> 3; h = v & 7; qt = 0; }
                    att::attn_unit<false>(lds, (const bf16_t*)(LP(PRM.ws) + WS_QB), (const bf16_t*)(LP(PRM.ws) + WS_KB), (const bf16_t*)(LP(PRM.ws) + WS_VT), (bf16_t*)(LP(PRM.ws) + WS_A), b, h, qt, 0.f, lam, lam_init_bits, PRM.in[I_SUBLN] + l * 128);
                }
            }
#endif
            }
        }
        SEAM(P + 4);
        if (RUN(P + 5)) {
#ifndef NO_G3
            { const int G_ = GDIM(), bx_ = BID(); const int nlat = NB * 4 * 128;
              for (int u = bx_; ; u += G_) { int b, h, c;
                  if (u < nlat) { c = 4 + (u & 127); h = (u >> 7) & 3; b = u >> 9; }
                  else { const int v = bx_ - (G_ - 32); if (last || v < 0) break; c = v & 3; h = (v >> 2) & 3; b = (v >> 4) & 1; }
                  gla_g3_unit(lds, l, b, h, c);
                  if (u >= nlat) break; } }
#endif
            __syncthreads();
            {
                pg8::Gemm g{(const bf16_t*)(LP(PRM.ws) + WS_PQ), (const bf16_t*)(LP(PRM.ws) + WS_WCS), 1024, 1024, 1024};
                pg8::Order S; if (last) S.init(64, 2, GDIM(), BID(), 1); else S.init(66, 2, GDIM(), BID(), 0);
                pg8::EpiBf16<0> E{(bf16_t*)(LP(PRM.ws) + WS_A) + 1536, DM, 0};
                pg8::gemm_phase(lds, g, S, E);
            }
        }
        SEAM(P + 5);
        if (RUN(P + 6)) for (int rep = 0; rep < NREP(6); ++rep) {
            pg8::Gemm g{(const bf16_t*)(LP(PRM.ws) + WS_A), (const bf16_t*)(LP(PRM.ws) + WS_WOUT), DM, DM, DM};
            pg8::Order S; S.init(64, 8, GDIM(), BID(), 1);
            pg8::EpiResid E{l == 0 ? (const void*)PRM.in[I_X] : (const void*)PRM.out, l == 0 ? (void*)PRM.out : (void*)(LP(PRM.ws) + WS_KV), (const float*)(LP(PRM.ws) + WS_MOD) + (size_t)l * 3 * 12288 + 2 * DM, l == 0 ? 0 : 1, 1};
            pg8::gemm_phase(lds, g, S, E);
            if (!last) {
                pg8::Gemm g2{(const bf16_t*)(LP(PRM.ws) + WS_A), (const bf16_t*)(LP(PRM.ws) + WS_WOUT), DM / NSPLIT, DM, DM};
                pg8::Order S2; S2.init(2, 8, GDIM(), BID(), 2, NSPLIT, DM / NSPLIT);
                pg8::EpiPartial E2{(float*)(LP(PRM.ws) + WS_PART), DM / NSPLIT};
                pg8::gemm_phase(lds, g2, S2, E2);
            }
        }
        SEAM(P + 6);
        if (RUN(P + 7)) phase_norm(l, 1, last, last ? 0 : 1, l, 2, l == 0 ? (const void*)PRM.out : (const void*)(LP(PRM.ws) + WS_KV), 1);
        SEAM(P + 7);
        if (RUN(P + 8)) for (int rep = 0; rep < NREP(8); ++rep) {
            pg8::Gemm g{(const bf16_t*)(LP(PRM.ws) + WS_A), (const bf16_t*)(LP(PRM.ws) + WS_WFF1), DM, DM, DM};
            pg8::Order S; if (last) S.init(64, 32, GDIM(), BID(), 1); else S.init(66, 32, GDIM(), BID(), 0);
            pg8::EpiBf16<1> E{(bf16_t*)(LP(PRM.ws) + WS_H), DFF, 0};
            pg8::gemm_phase(lds, g, S, E);
        }
        SEAM(P + 8);
        if (RUN(P + 9)) {
            pg8::Gemm g{(const bf16_t*)(LP(PRM.ws) + WS_H), (const bf16_t*)(LP(PRM.ws) + WS_WFF2), DFF, DFF, DFF};
            pg8::Order S; S.init(64, 8, GDIM(), BID(), 1);
            pg8::EpiResid E{l == 0 ? (const void*)PRM.out : (const void*)(LP(PRM.ws) + WS_KV), (void*)PRM.out, (const float*)(LP(PRM.ws) + WS_MOD) + (size_t)l * 3 * 12288 + 5 * DM, 1, l == 0 ? 1 : 0};
            pg8::gemm_phase(lds, g, S, E);
            if (NREP(9) == 2) {
                pg8::Gemm g3{(const bf16_t*)(LP(PRM.ws) + WS_H), (const bf16_t*)(LP(PRM.ws) + WS_WFF2), DFF, DFF, DFF};
                pg8::Order S3; S3.init(64, 8, GDIM(), BID(), 1);
                pg8::EpiBf16<0> E3{(bf16_t*)(LP(PRM.ws) + WS_T + ((size_t)64 << 20)), DM, 0};
                pg8::gemm_phase(lds, g3, S3, E3);
            }
            if (!last) {
                pg8::Gemm g2{(const bf16_t*)(LP(PRM.ws) + WS_H), (const bf16_t*)(LP(PRM.ws) + WS_WFF2), DFF / NSPLIT, DFF, DFF};
                pg8::Order S2; S2.init(2, 8, GDIM(), BID(), 2, NSPLIT, DFF / NSPLIT);
                pg8::EpiPartial E2{(float*)(LP(PRM.ws) + WS_PART), DFF / NSPLIT};
                pg8::gemm_phase(lds, g2, S2, E2);
            }
        }
        SEAM(P + 9);
    }
}

extern "C" void kernel_launch(void* const* d_in, const int* in_sizes, int n_in, void* d_out, int out_size, void* d_ws, size_t ws_size, hipStream_t stream) {
    static int grid = 0;
    if (grid == 0) {
        if (n_in != 20 || out_size != NB * SEQ * DM || ws_size < WS_END) { fprintf(stderr, "kernel_launch: unexpected problem (n_in %d out %d ws %zu need %zu)\n", n_in, out_size, ws_size, (size_t)WS_END); grid = -1; return; }
        int dev = 0, cus = 0, per_cu = 0;
        hipGetDevice(&dev); hipDeviceGetAttribute(&cus, hipDeviceAttributeMultiprocessorCount, dev);
        if (hipFuncSetAttribute((const void*)mega, hipFuncAttributeMaxDynamicSharedMemorySize, LDS_BYTES) != hipSuccess) { fprintf(stderr, "kernel_launch: hipFuncSetAttribute failed\n"); grid = -1; return; }
        if (hipOccupancyMaxActiveBlocksPerMultiprocessor(&per_cu, (const void*)mega, 512, LDS_BYTES) != hipSuccess || per_cu < 1) { fprintf(stderr, "kernel_launch: occupancy query says %d\n", per_cu); per_cu = 1; }
        (void)hipGetLastError();
        grid = cus;
    }
    if (grid < 0) return;
    Params p{};
    for (int i = 0; i < 20; ++i) p.in[i] = (const float*)d_in[i];
    p.out = (float*)d_out; p.ws = (unsigned char*)d_ws; p.ph_lo = 0; p.ph_hi = 20; p.coop = 1; p.pad = 0;
    if (hipMemsetAsync((char*)d_ws + WS_BAR, 0, 16384, stream) != hipSuccess) { fprintf(stderr, "kernel_launch: memset of barrier words failed\n"); return; }
    void* args[] = {&p};
    hipError_t e = hipLaunchCooperativeKernel((const void*)mega, dim3(grid), dim3(512), args, LDS_BYTES, stream);
    if (e != hipSuccess) fprintf(stderr, "cooperative launch failed: %s (grid %d)\n", hipGetErrorString(e), grid);
}
```

```cpp
#include <hip/hip_runtime.h>
#include <hip/hip_cooperative_groups.h>
#include <cstdio>
#include <cstdint>
namespace cg = cooperative_groups;

#define LAS __attribute__((address_space(3)))
typedef unsigned short bf16_t;
typedef short bf16x8 __attribute__((ext_vector_type(8)));
typedef float f32x4 __attribute__((ext_vector_type(4)));
typedef float f32x16 __attribute__((ext_vector_type(16)));
typedef unsigned u32x4 __attribute__((ext_vector_type(4)));
typedef unsigned u32x2 __attribute__((ext_vector_type(2)));
#define DI __device__ __forceinline__
#define LDS_WAIT() asm volatile("s_waitcnt lgkmcnt(0)" ::: "memory")

constexpr int DM = 2048, NB = 2, SEQ = 8192, CTXL = 256, TPB = SEQ + CTXL  , MROWS = NB * TPB  ;
constexpr int DIN = 5152, NIN = 5376, DFF = 8192, P2W = 2304, NCH = TPB / 64  ;
constexpr float EPS = 1e-6f;
constexpr float QSCALE = 0.18033688011112042f;
constexpr float LOG2E = 1.4426950408889634f;

constexpr size_t al256(size_t x) { return (x + 255) & ~(size_t)255; }
constexpr size_t WS_MOD = 0;
constexpr size_t WS_XC = al256(WS_MOD + (size_t)2 * 3 * 12288 * 4);
constexpr size_t WS_WIN = al256(WS_XC + (size_t)512 * DM * 4);
constexpr size_t WS_WOUT = al256(WS_WIN + (size_t)NIN * DM * 2);
constexpr size_t WS_WFF1 = al256(WS_WOUT + (size_t)DM * DM * 2);
constexpr size_t WS_WFF2 = al256(WS_WFF1 + (size_t)DFF * DM * 2);
constexpr size_t WS_WCS = al256(WS_WFF2 + (size_t)DM * DFF * 2);
constexpr size_t WS_TCTX = al256(WS_WCS + (size_t)512 * 1024 * 2);
constexpr size_t WS_A = al256(WS_TCTX + (size_t)512 * 256 * 2);
constexpr size_t WS_QB = al256(WS_A + (size_t)MROWS * DM * 2);
constexpr size_t WS_KB = al256(WS_QB + (size_t)MROWS * 1024 * 2);
constexpr size_t WS_VB = al256(WS_KB + (size_t)MROWS * 1024 * 2);
constexpr size_t WS_VT = al256(WS_VB + (size_t)MROWS * 1024 * 2);
constexpr size_t WS_P2 = al256(WS_VT + (size_t)MROWS * 1024 * 2);
constexpr size_t WS_T = al256(WS_P2 + (size_t)MROWS * P2W * 2);
constexpr size_t WS_B2T = WS_T;
constexpr size_t WS_A1 = WS_T + ((size_t)100 << 20);
constexpr size_t WS_A2 = WS_A1 + 65536;
constexpr size_t WS_H = WS_QB;
constexpr size_t WS_UTL = al256(WS_T + (size_t)8448 * 8192 * 2);
constexpr size_t WS_UTC = al256(WS_UTL + (size_t)1024 * 8192 * 2);
constexpr size_t WS_PQ = al256(WS_UTC + (size_t)1024 * 256 * 2);
constexpr size_t WS_KV = al256(WS_PQ + (size_t)MROWS * 1024 * 2);
constexpr size_t WS_DEC = al256(WS_KV + (size_t)16 * NCH * 8192 * 4);
constexpr size_t WS_PART = al256(WS_DEC + (size_t)16 * NCH * 64 * 4);
constexpr size_t WS_BAR = al256(WS_PART + (size_t)8 * 512 * DM * 4);
constexpr size_t WS_END = WS_BAR + 16384;
constexpr int NSPLIT = 8;
static_assert(WS_H + (size_t)MROWS * DFF * 2 <= WS_UTL, "H overlay must end before UTL");
static_assert(WS_KB - WS_QB == (size_t)MROWS * 2048 && WS_VB - WS_KB == (size_t)MROWS * 2048 && WS_P2 - WS_QB == 4 * (size_t)MROWS * 2048, "in-proj destinations at fixed strides");

constexpr int LDS_BYTES = 160768;
#ifndef REPK
#define REPK -1
#endif
#define NREP(k) ((l == 0 && (k) == REPK) ? 2 : 1)

DI unsigned f2bf(float f) { unsigned u = __builtin_bit_cast(unsigned, f); return (u + 0x7fffu + ((u >> 16) & 1u)) >> 16; }
DI unsigned pk2(float lo, float hi) { return f2bf(lo) | (f2bf(hi) << 16); }
DI float bf2f(unsigned h) { return __builtin_bit_cast(float, h << 16); }
DI unsigned cvt_pk_bf16(float lo, float hi) { unsigned r; asm volatile("v_cvt_pk_bf16_f32 %0, %1, %2" : "=v"(r) : "v"(lo), "v"(hi)); return r; }
DI int TID() { int t = threadIdx.x; asm volatile("" : "+v"(t)); return t; }
DI int BID() { int t = blockIdx.x; asm volatile("" : "+s"(t)); return t; }
DI int GDIM() { int t = gridDim.x; asm volatile("" : "+s"(t)); return t; }
template <class T> DI T* LP(T* p) { asm volatile("" : "+s"(p)); return p; }
DI float wave_sum(float v) {
#pragma unroll
    for (int o = 1; o < 64; o <<= 1) v += __shfl_xor(v, o);
    return v;
}
DI float logsig(float z) { return fminf(z, 0.f) - __logf(1.f + __expf(-fabsf(z))); }

namespace pg8 {
constexpr int BM = 256, BK = 64, HALF = 128, HTB = HALF * BK * 2, STAGE_BYTES = 8 * HTB, NXCD = 8, WGM = 8;
DI int lds_byte(int r, int c) { const int st = (r >> 4) * 2 + (c >> 5), rr = r & 15, cc = c & 31, ob = rr * 64 + cc * 2; return st * 1024 + (ob ^ (((ob >> 9) & 1) << 5)); }
DI void stage_rc(int b, int& R, int& C) { const int st = b / 1024, sb = b % 1024, swz = sb ^ (((sb >> 9) & 1) << 5); R = (st >> 1) * 16 + swz / 64; C = (st & 1) * 32 + (swz % 64) / 2; }
DI int perm32(int rho) { const int n = rho >> 4, i = rho & 15; return 8 * (i >> 2) + 4 * n + (i & 3); }
struct Unit { int pm, pn, ko; };
struct Gemm { const bf16_t* A; const bf16_t* Bt; int K, lda, ldb; };
struct Order {
    int nM, nN, nwg, G, c, skip, nK, ksub;
    DI void init(int nM_, int nN_, int G_, int c_, int skip_, int nK_ = 1, int ksub_ = 0) { nM = nM_; nN = nN_; nwg = nM * nN; G = G_; c = c_; skip = skip_; nK = nK_; ksub = ksub_; }
    DI bool next(int i, Unit& u) const {
        if (c < 0 || c >= G) return false;
        const int L = i * G + c; if (L >= nwg * nK) return false;
        int wgid = L % nwg; u.ko = (L / nwg) * ksub;
        { const int q = nwg / NXCD, r = nwg % NXCD, xcd = wgid % NXCD, off = wgid / NXCD; wgid = (xcd < r ? xcd * (q + 1) : r * (q + 1) + (xcd - r) * q) + off; }
        const int nig = WGM * nN, gid = wgid / nig, fm = gid * WGM, gsz = (nM - fm) < WGM ? (nM - fm) : WGM;
        int pm = fm + ((wgid % nig) % gsz); u.pn = (wgid % nig) / gsz;
        if (skip == 1) pm = pm + 1 + (pm >= 32 ? 1 : 0);
        if (skip == 2) pm = pm * 33;
        u.pm = pm; return true;
    }
};

template <class Epi>
DI void gemm_phase(LAS unsigned char* lds, const Gemm g, const Order& S, const Epi& E) {
    const int tid = TID(), wid = __builtin_amdgcn_readfirstlane(tid >> 6), lane = tid & 63, wr = wid >> 2, wc = wid & 3, fr = lane & 15, fq = lane >> 4;
    int K = g.K; asm volatile("" : "+s"(K));
    const int nt = K / BK;
    unsigned voffA[2], voffB[2];
#pragma unroll
    for (int i = 0; i < 2; ++i) { int R, C; stage_rc(tid * 16 + i * 8192, R, C); const int Rb = Epi::PERM ? ((R & ~31) + perm32(R & 31)) : R;
        voffA[i] = (unsigned)(R * g.lda + C) * 2u; voffB[i] = (unsigned)(Rb * g.ldb + C) * 2u; }
    const size_t kstep = (size_t)(BK * 2);
    const size_t hstepA = (size_t)HALF * g.lda * 2, hstepB = (size_t)HALF * g.ldb * 2;
    const size_t tstepA = 2 * hstepA, tstepB = 2 * hstepB;
    const unsigned ldsw = (unsigned)wid * 1024u;
    const int aoff = lds_byte(wr * 64 + fr, fq * 8), boff = lds_byte(wc * 32 + fr, fq * 8);
#define PG8_SA(b, h) (((b) * 2 + (h)) * HTB)
#define PG8_SB(b, h) ((4 + (b) * 2 + (h)) * HTB)
#define PG8_STAGE(bufoff, gbase, voff) do { _Pragma("unroll") for (int _i = 0; _i < 2; ++_i) \
        __builtin_amdgcn_global_load_lds((const unsigned*)((const char*)(gbase) + (voff)[_i]), (LAS unsigned*)(lds + (bufoff) + ldsw + _i * 8192), 16, 0, 0); } while (0)
#define PG8_LDA(dst, b, h) do { _Pragma("unroll") for (int m = 0; m < 4; ++m) _Pragma("unroll") for (int k = 0; k < 2; ++k) dst[m][k] = *(const LAS bf16x8*)(lds + PG8_SA(b, h) + aoff + m * 2048 + k * 1024); } while (0)
#define PG8_LDB(dst, b, h) do { _Pragma("unroll") for (int n = 0; n < 2; ++n) _Pragma("unroll") for (int k = 0; k < 2; ++k) dst[n][k] = *(const LAS bf16x8*)(lds + PG8_SB(b, h) + boff + n * 2048 + k * 1024); } while (0)
#define PG8_MMA(ai, bj, At, Bt) do { __builtin_amdgcn_s_setprio(1); _Pragma("unroll") for (int m = 0; m < 4; ++m) _Pragma("unroll") for (int n = 0; n < 2; ++n) _Pragma("unroll") for (int k = 0; k < 2; ++k) \
        acc[ai][bj][m][n] = __builtin_amdgcn_mfma_f32_16x16x32_bf16(Bt[n][k], At[m][k], acc[ai][bj][m][n], 0, 0, 0); __builtin_amdgcn_s_setprio(0); } while (0)
#define PG8_WAIT_V(n) asm volatile("s_waitcnt vmcnt(" #n ")" ::: "memory")
#define PG8_WAIT_L(n) asm volatile("s_waitcnt lgkmcnt(" #n ")" ::: "memory")
#define PG8_BAR __builtin_amdgcn_s_barrier()
#define PG8_SCHED __builtin_amdgcn_sched_barrier(0)
    Unit cur, nxt; int ui = 0;
    if (!S.next(0, cur)) return;
    f32x4 acc[2][2][4][2];
#pragma unroll
    for (int a = 0; a < 2; ++a)
#pragma unroll
        for (int b = 0; b < 2; ++b)
#pragma unroll
            for (int m = 0; m < 4; ++m)
#pragma unroll
                for (int n = 0; n < 2; ++n) acc[a][b][m][n] = (f32x4){0.f, 0.f, 0.f, 0.f};
    bf16x8 At[4][2], B0[2][2], B1[2][2];
    const char* cA = (const char*)g.A + (size_t)cur.pm * tstepA + (size_t)cur.ko * 2; const char* cB = (const char*)g.Bt + (size_t)cur.pn * tstepB + (size_t)cur.ko * 2;
    PG8_STAGE(PG8_SB(0, 0), cB, voffB); PG8_STAGE(PG8_SB(0, 1), cB + hstepB, voffB); PG8_STAGE(PG8_SA(0, 0), cA, voffA); PG8_STAGE(PG8_SA(0, 1), cA + hstepA, voffA);
    if (wr == 1) PG8_BAR;
    PG8_WAIT_V(2); PG8_BAR;
    PG8_STAGE(PG8_SB(1, 0), cB + kstep, voffB); PG8_STAGE(PG8_SA(1, 0), cA + kstep, voffA); PG8_STAGE(PG8_SB(1, 1), cB + hstepB + kstep, voffB);
    PG8_WAIT_V(6); PG8_BAR;
    for (;;) {
        const bool has_next = S.next(ui + 1, nxt);
        const char* nA = has_next ? (const char*)g.A + (size_t)nxt.pm * tstepA + (size_t)nxt.ko * 2 : cA; const char* nB = has_next ? (const char*)g.Bt + (size_t)nxt.pn * tstepB + (size_t)nxt.ko * 2 : cB;
        for (int t = 0; t < nt; t += 2) {
            const bool last = (t == nt - 2);
            const char* a1 = cA + (size_t)(t + 1) * kstep;
            const char* a2 = last ? nA : cA + (size_t)(t + 2) * kstep; const char* b2 = last ? nB : cB + (size_t)(t + 2) * kstep;
            const char* a3 = a2 + kstep; const char* b3 = b2 + kstep;
            PG8_LDB(B0, 0, 0); PG8_LDB(B1, 0, 1); PG8_SCHED; PG8_LDA(At, 0, 0); PG8_STAGE(PG8_SA(1, 1), a1 + hstepA, voffA);
            PG8_WAIT_V(8); PG8_WAIT_L(0); PG8_BAR; PG8_MMA(0, 0, At, B0); PG8_MMA(0, 1, At, B1); PG8_BAR; PG8_SCHED;
            PG8_LDA(At, 0, 1); PG8_STAGE(PG8_SB(0, 0), b2, voffB); PG8_STAGE(PG8_SB(0, 1), b2 + hstepB, voffB); PG8_STAGE(PG8_SA(0, 0), a2, voffA);
            PG8_WAIT_V(8); PG8_WAIT_L(0); PG8_BAR; PG8_MMA(1, 0, At, B0); PG8_MMA(1, 1, At, B1); PG8_BAR; PG8_SCHED;
            PG8_LDB(B0, 1, 0); PG8_LDB(B1, 1, 1); PG8_SCHED; PG8_LDA(At, 1, 0); PG8_STAGE(PG8_SA(0, 1), a2 + hstepA, voffA);
            PG8_WAIT_V(8); PG8_WAIT_L(0); PG8_BAR; PG8_MMA(0, 0, At, B0); PG8_MMA(0, 1, At, B1); PG8_BAR; PG8_SCHED;
            PG8_LDA(At, 1, 1); PG8_STAGE(PG8_SB(1, 0), b3, voffB); PG8_STAGE(PG8_SB(1, 1), b3 + hstepB, voffB); PG8_STAGE(PG8_SA(1, 0), a3, voffA);
            PG8_WAIT_V(8); PG8_WAIT_L(0); PG8_BAR; PG8_MMA(1, 0, At, B0); PG8_MMA(1, 1, At, B1); PG8_BAR; PG8_SCHED;
        }
        if (wr == 0) PG8_BAR;
        E(acc, cur, wr, wc, fr, fq);
        if (!has_next) break;
#pragma unroll
        for (int a = 0; a < 2; ++a)
#pragma unroll
            for (int b = 0; b < 2; ++b)
#pragma unroll
                for (int m = 0; m < 4; ++m)
#pragma unroll
                    for (int n = 0; n < 2; ++n) acc[a][b][m][n] = (f32x4){0.f, 0.f, 0.f, 0.f};
        cur = nxt; cA = nA; cB = nB; ++ui;
        if (wr == 1) PG8_BAR;
    }
    PG8_WAIT_V(0);
    PG8_BAR;
#undef PG8_SA
#undef PG8_SB
#undef PG8_STAGE
#undef PG8_LDA
#undef PG8_LDB
#undef PG8_MMA
#undef PG8_WAIT_V
#undef PG8_WAIT_L
#undef PG8_BAR
#undef PG8_SCHED
}

template <int ACT> struct EpiBf16 {
    static constexpr bool PERM = true;
    bf16_t* d0; int ld0; int split;
    DI void operator()(const f32x4 (&acc)[2][2][4][2], const Unit& u, int wr, int wc, int fr_, int fq_) const {
        int fr = fr_, fq = fq_; asm volatile("" : "+v"(fr), "+v"(fq));
        bf16_t* base = d0; int ldc = ld0, t0 = 0;
        if (split) { const int sg = (u.pn >> 2) < 3 ? (u.pn >> 2) : 3; base = d0 + (size_t)(sg < 3 ? sg : 4) * ((size_t)MROWS * 1024); ldc = sg < 3 ? 1024 : P2W; t0 = sg * 4; }
        const int row0 = u.pm * BM + wr * 64 + fr, col0 = (u.pn - t0) * BM + wc * 32 + 8 * fq;
#pragma unroll
        for (int ai = 0; ai < 2; ++ai)
#pragma unroll
            for (int m = 0; m < 4; ++m) { bf16_t* rowp = base + (size_t)(row0 + ai * HALF + m * 16) * ldc + col0;
#pragma unroll
                for (int bj = 0; bj < 2; ++bj) { f32x4 v0 = acc[ai][bj][m][0], v1 = acc[ai][bj][m][1];
                    if (ACT == 1) {
#pragma unroll
                        for (int j = 0; j < 4; ++j) { const float a = fmaxf(v0[j], 0.f), b = fmaxf(v1[j], 0.f); v0[j] = a * a; v1[j] = b * b; } }
                    u32x4 w; w.x = cvt_pk_bf16(v0[0], v0[1]); w.y = cvt_pk_bf16(v0[2], v0[3]); w.z = cvt_pk_bf16(v1[0], v1[1]); w.w = cvt_pk_bf16(v1[2], v1[3]);
                    *(u32x4*)(rowp + bj * HALF) = w; } }
    }
};
struct EpiResid {
    static constexpr bool PERM = true;
    const void* src; void* dst; const float* gate; int sb, db;
    DI void operator()(const f32x4 (&acc)[2][2][4][2], const Unit& u, int wr, int wc, int fr_, int fq_) const {
        int fr = fr_, fq = fq_; asm volatile("" : "+v"(fr), "+v"(fq));
        const int b = u.pm / 33, tt = u.pm % 33;
        const size_t roff = ((size_t)b * SEQ + (size_t)(tt - 1) * 256) * DM;
        const float* gp = gate + (size_t)b * 12288;
        const int col0 = u.pn * BM + wc * 32 + 8 * fq;
        f32x4 gq[2][2];
#pragma unroll
        for (int bj = 0; bj < 2; ++bj) { gq[bj][0] = *(const f32x4*)(gp + col0 + bj * HALF); gq[bj][1] = *(const f32x4*)(gp + col0 + bj * HALF + 4); }
        if (sb) {
#pragma unroll
            for (int ai = 0; ai < 2; ++ai) {
                u32x4 pre[4][2];
#pragma unroll
                for (int m = 0; m < 4; ++m) { const size_t off = roff + (size_t)(ai * HALF + wr * 64 + m * 16 + fr) * DM + col0;
#pragma unroll
                    for (int bj = 0; bj < 2; ++bj) pre[m][bj] = *(const u32x4*)((const bf16_t*)src + off + bj * HALF); }
#pragma unroll
                for (int m = 0; m < 4; ++m) { const size_t off = roff + (size_t)(ai * HALF + wr * 64 + m * 16 + fr) * DM + col0;
#pragma unroll
                    for (int bj = 0; bj < 2; ++bj) { const int cc = bj * HALF; const u32x4 w = pre[m][bj];
                        const f32x4 s0 = (f32x4){bf2f(w.x & 0xffff), bf2f(w.x >> 16), bf2f(w.y & 0xffff), bf2f(w.y >> 16)}, s1 = (f32x4){bf2f(w.z & 0xffff), bf2f(w.z >> 16), bf2f(w.w & 0xffff), bf2f(w.w >> 16)};
                        const f32x4 o0 = s0 + gq[bj][0] * acc[ai][bj][m][0], o1 = s1 + gq[bj][1] * acc[ai][bj][m][1];
                        if (db) { u32x4 o; o.x = cvt_pk_bf16(o0[0], o0[1]); o.y = cvt_pk_bf16(o0[2], o0[3]); o.z = cvt_pk_bf16(o1[0], o1[1]); o.w = cvt_pk_bf16(o1[2], o1[3]); *(u32x4*)((bf16_t*)dst + off + cc) = o; }
                        else { *(f32x4*)((float*)dst + off + cc) = o0; *(f32x4*)((float*)dst + off + cc + 4) = o1; } } }
                asm volatile("" ::: "memory"); }
        } else {
#pragma unroll
            for (int ai = 0; ai < 2; ++ai)
#pragma unroll
                for (int m = 0; m < 4; ++m) { const size_t off = roff + (size_t)(ai * HALF + wr * 64 + m * 16 + fr) * DM + col0;
#pragma unroll
                    for (int bj = 0; bj < 2; ++bj) { const int cc = bj * HALF;
                        const f32x4 s0 = *(const f32x4*)((const float*)src + off + cc), s1 = *(const f32x4*)((const float*)src + off + cc + 4);
                        const f32x4 o0 = s0 + gq[bj][0] * acc[ai][bj][m][0], o1 = s1 + gq[bj][1] * acc[ai][bj][m][1];
                        if (db) { u32x4 o; o.x = cvt_pk_bf16(o0[0], o0[1]); o.y = cvt_pk_bf16(o0[2], o0[3]); o.z = cvt_pk_bf16(o1[0], o1[1]); o.w = cvt_pk_bf16(o1[2], o1[3]); *(u32x4*)((bf16_t*)dst + off + cc) = o; }
                        else { *(f32x4*)((float*)dst + off + cc) = o0; *(f32x4*)((float*)dst + off + cc + 4) = o1; } }
                    if (m & 1) asm volatile("" ::: "memory"); }
        }
    }
};
struct EpiPartial {
    static constexpr bool PERM = true;
    float* part; int ksub;
    DI void operator()(const f32x4 (&acc)[2][2][4][2], const Unit& u, int wr, int wc, int fr_, int fq_) const {
        int fr = fr_, fq = fq_; asm volatile("" : "+v"(fr), "+v"(fq));
        const int b = u.pm / 33, ks = u.ko / ksub;
        float* dp = part + ((size_t)ks * 512 + (size_t)b * 256) * DM;
        const int col0 = u.pn * BM + wc * 32 + 8 * fq;
#pragma unroll
        for (int ai = 0; ai < 2; ++ai)
#pragma unroll
            for (int m = 0; m < 4; ++m) { float* q = dp + (size_t)(ai * HALF + wr * 64 + m * 16 + fr) * DM + col0;
#pragma unroll
                for (int bj = 0; bj < 2; ++bj) { *(f32x4*)(q + bj * HALF) = acc[ai][bj][m][0]; *(f32x4*)(q + bj * HALF + 4) = acc[ai][bj][m][1]; } }
    }
};
struct EpiDft1 {
    static constexpr bool PERM = false;
    bf16_t* B2t;
    DI void operator()(const f32x4 (&acc)[2][2][4][2], const Unit& u, int wr, int wc, int fr_, int fq_) const {
        int fr = fr_, fq = fq_; asm volatile("" : "+v"(fr), "+v"(fq));
#pragma unroll
        for (int m = 0; m < 4; ++m) { const int c = wr * 64 + m * 16 + fr;
#pragma unroll
            for (int bj = 0; bj < 2; ++bj)
#pragma unroll
                for (int n = 0; n < 2; ++n) { const int nl = bj * HALF + wc * 32 + n * 16 + 4 * fq; const int colg = u.pn * 4 + (nl >> 6), b0 = nl & 63;
                    const f32x4 ar = acc[0][bj][m][n], ai = acc[1][bj][m][n]; float xr[4], xi[4];
#pragma unroll
                    for (int j = 0; j < 4; ++j) { const float ph = (float)((b0 + j) * c) * (6.283185307179586f / 8192.f); const float cs = __cosf(ph), sn = __sinf(ph);
                        xr[j] = ar[j] * cs + ai[j] * sn; xi[j] = ai[j] * cs - ar[j] * sn; }
                    bf16_t* q = B2t + ((size_t)c * 1024 + colg) * 128 + b0;
                    u32x2 w; w.x = cvt_pk_bf16(xr[0], xr[1]); w.y = cvt_pk_bf16(xr[2], xr[3]); *(u32x2*)q = w;
                    w.x = cvt_pk_bf16(xi[0], xi[1]); w.y = cvt_pk_bf16(xi[2], xi[3]); *(u32x2*)(q + 64) = w; } }
    }
};
struct EpiDft2 {
    static constexpr bool PERM = true;
    bf16_t* PQ;
    DI void operator()(const f32x4 (&acc)[2][2][4][2], const Unit& u, int wr, int wc, int fr_, int fq_) const {
        int fr = fr_, fq = fq_; asm volatile("" : "+v"(fr), "+v"(fq));
        const int c = u.pn >> 2;
#pragma unroll
        for (int m = 0; m < 4; ++m) { const int d = m * 16 + fr;
#pragma unroll
            for (int bj = 0; bj < 2; ++bj) { const int colg = (u.pn & 3) * BM + bj * HALF + wc * 32 + 8 * fq; const int batch = colg >> 9, ch = colg & 511;
                const f32x4 v0 = acc[0][bj][m][0], v1 = acc[0][bj][m][1];
                u32x4 w; w.x = cvt_pk_bf16(v0[0], v0[1]); w.y = cvt_pk_bf16(v0[2], v0[3]); w.z = cvt_pk_bf16(v1[0], v1[1]); w.w = cvt_pk_bf16(v1[2], v1[3]);
                *(u32x4*)(PQ + ((size_t)batch * TPB + CTXL + c + 128 * d) * 1024 + wr * 512 + ch) = w; } }
    }
};
struct EpiDftCtx {
    static constexpr bool PERM = false;
    bf16_t* PQ;
    DI void operator()(const f32x4 (&acc)[2][2][4][2], const Unit& u, int wr, int wc, int fr_, int fq_) const {
        int fr = fr_, fq = fq_; asm volatile("" : "+v"(fr), "+v"(fq));
        const int b = u.pn >> 1; const int colt = (u.pn & 1) * BM + wc * 32 + 4 * fq;
        bf16_t* base = PQ + (size_t)b * TPB * 1024 + (u.pm ? 512 : 0);
#pragma unroll
        for (int ai = 0; ai < 2; ++ai)
#pragma unroll
            for (int m = 0; m < 4; ++m) { const int k1 = ai * HALF + wr * 64 + m * 16 + fr;
#pragma unroll
                for (int bj = 0; bj < 2; ++bj)
#pragma unroll
                    for (int n = 0; n < 2; ++n) { const int c = colt + bj * HALF + n * 16; const f32x4 v = acc[ai][bj][m][n];
                        u32x2 w; w.x = cvt_pk_bf16(v[0], v[1]); w.y = cvt_pk_bf16(v[2], v[3]);
                        *(u32x2*)(base + (size_t)k1 * 1024 + c) = w; } }
    }
};
}

namespace att {
constexpr int QP = 272, VP = 144;
constexpr int Q_OFF = 0, K_OFF = 256 * QP  , K_BYTES = 64 * QP  , V_OFF = K_OFF + 2 * K_BYTES  , V_BYTES = 128 * VP  ;
static_assert(V_OFF + 3 * V_BYTES <= LDS_BYTES - 16, "attention LDS (3 V buffers)");
#define MFMA32(a, b, c) __builtin_amdgcn_mfma_f32_32x32x16_bf16((a), (b), (c), 0, 0, 0)
DI bf16x8 pack8(float a0, float a1, float a2, float a3, float a4, float a5, float a6, float a7) {
    u32x4 p;
    asm volatile("v_cvt_pk_bf16_f32 %0, %4, %5\n\tv_cvt_pk_bf16_f32 %1, %6, %7\n\tv_cvt_pk_bf16_f32 %2, %8, %9\n\tv_cvt_pk_bf16_f32 %3, %10, %11\n\ts_nop 1"
                 : "=&v"(p[0]), "=&v"(p[1]), "=&v"(p[2]), "=&v"(p[3])
                 : "v"(a0), "v"(a1), "v"(a2), "v"(a3), "v"(a4), "v"(a5), "v"(a6), "v"(a7));
    return __builtin_bit_cast(bf16x8, p);
}
template <bool SHIFT> DI void attn_unit(LAS unsigned char* lds, const bf16_t* Qb, const bf16_t* Kb, const bf16_t* Vt, bf16_t* concat,
                  int b, int h, int qt, float shift2, float lam, int lam_init_bits, const float* subln_g) {
    const int tid = TID(), wid = __builtin_amdgcn_readfirstlane(tid >> 6), lane = tid & 63, r = lane & 31, hh = lane >> 5;
    const size_t rowbase = (size_t)b * TPB;
    const int q0 = qt * 256;
    const int nkt = (qt == 0) ? 4 : NCH;
    const bf16_t* kg = Kb + rowbase * 1024 + h * 128;
    const bf16_t* vg = Vt + ((size_t)(b * 8 + h) * 128) * TPB;
    const int krow0 = tid >> 4, kc = tid & 15;
    const int vrow0 = tid >> 3, vc = tid & 7;
#pragma unroll
    for (int i = 0; i < 8; ++i) { const int id = i * 512 + tid, row = id >> 4, c = id & 15;
        const u32x4 v = *(const u32x4*)(Qb + (rowbase + q0 + row) * 1024 + h * 128 + c * 8);
        *(LAS u32x4*)(lds + Q_OFF + row * QP + c * 16) = v; }
    u32x4 sg0, sg1;
    sg0 = *(const u32x4*)(kg + (size_t)(krow0) * 1024 + kc * 8); sg1 = *(const u32x4*)(kg + (size_t)(krow0 + 32) * 1024 + kc * 8);
    *(LAS u32x4*)(lds + K_OFF + krow0 * QP + kc * 16) = sg0; *(LAS u32x4*)(lds + K_OFF + (krow0 + 32) * QP + kc * 16) = sg1;
    sg0 = *(const u32x4*)(vg + (size_t)(vrow0) * TPB + vc * 8); sg1 = *(const u32x4*)(vg + (size_t)(vrow0 + 64) * TPB + vc * 8);
    *(LAS u32x4*)(lds + V_OFF + vrow0 * VP + vc * 16) = sg0; *(LAS u32x4*)(lds + V_OFF + (vrow0 + 64) * VP + vc * 16) = sg1;
    if (nkt > 1) { sg0 = *(const u32x4*)(kg + (size_t)(64 + krow0) * 1024 + kc * 8); sg1 = *(const u32x4*)(kg + (size_t)(64 + krow0 + 32) * 1024 + kc * 8); }
    __syncthreads();
    f32x16 OT[2][4];
#pragma unroll
    for (int m = 0; m < 2; ++m)
#pragma unroll
        for (int t = 0; t < 4; ++t)
#pragma unroll
            for (int i = 0; i < 16; ++i) OT[m][t][i] = 0.f;
    float lsum[2] = {0.f, 0.f};
    const LAS unsigned char* qrow = lds + Q_OFF + (32 * wid + r) * QP + hh * 16;
#define SB0() __builtin_amdgcn_sched_barrier(0)
#define QKEXP(P_, half_) do { _Pragma("unroll") for (int m = 0; m < 2; ++m) { \
        f32x16 st; _Pragma("unroll") for (int i = 0; i < 16; ++i) st[i] = 0.f; \
        bf16x8 fq, fk; \
        fq = *(const LAS bf16x8*)(qrow + m * 128); fk = *(const LAS bf16x8*)(kb + (half_) * 32 * QP + m * 128); \
        _Pragma("unroll") for (int s = 0; s < 4; ++s) { \
            SB0(); st = MFMA32(fk, fq, st); SB0(); \
            if (s < 3) { fq = *(const LAS bf16x8*)(qrow + m * 128 + (s + 1) * 32); fk = *(const LAS bf16x8*)(kb + (half_) * 32 * QP + m * 128 + (s + 1) * 32); } } \
        float ls = 0.f; \
        _Pragma("unroll") for (int g_ = 0; g_ < 2; ++g_) { float e_[8]; _Pragma("unroll") for (int i_ = 0; i_ < 8; ++i_) { e_[i_] = __builtin_amdgcn_exp2f(SHIFT ? st[8 * g_ + i_] - shift2 : st[8 * g_ + i_]); ls += e_[i_]; } \
            P_[m][g_] = pack8(e_[0], e_[1], e_[2], e_[3], e_[4], e_[5], e_[6], e_[7]); } \
        lsum[m] += ls; } } while (0)
#define PVH(P_, vptr_) do { bf16x8 fv; fv = *(const LAS bf16x8*)(vptr_); \
        _Pragma("unroll") for (int it = 0; it < 8; ++it) { const int mt = it & 3, sI = it >> 2; \
            SB0(); OT[0][mt] = MFMA32(fv, P_[0][sI], OT[0][mt]); OT[1][mt] = MFMA32(fv, P_[1][sI], OT[1][mt]); SB0(); \
            if (it < 7) { const int mt2 = (it + 1) & 3, s2 = (it + 1) >> 2; fv = *(const LAS bf16x8*)((vptr_) + mt2 * 32 * VP + s2 * 32); } } } while (0)
    const bool lag = wid >= 4;
    bf16x8 Pc[2][2];
#pragma unroll
    for (int m = 0; m < 2; ++m)
#pragma unroll
        for (int g = 0; g < 2; ++g) { u32x4 z = {0u, 0u, 0u, 0u}; Pc[m][g] = __builtin_bit_cast(bf16x8, z); }
    const LAS unsigned char* vold = lds + V_OFF + r * VP + hh * 16;
    int vcur = 0;
    for (int kt = 0; kt < nkt; ++kt) {
        const int cur = kt & 1, nx = cur ^ 1;
        const int vnx = vcur == 2 ? 0 : vcur + 1;
        const bool pf = (kt + 1 < nkt);
        const size_t ko = (size_t)(kt + 1) * 64;
        if (pf) { *(LAS u32x4*)(lds + K_OFF + nx * K_BYTES + krow0 * QP + kc * 16) = sg0; *(LAS u32x4*)(lds + K_OFF + nx * K_BYTES + (krow0 + 32) * QP + kc * 16) = sg1;
            sg0 = *(const u32x4*)(vg + (size_t)(vrow0) * TPB + ko + vc * 8); sg1 = *(const u32x4*)(vg + (size_t)(vrow0 + 64) * TPB + ko + vc * 8); }
        const LAS unsigned char* kb = lds + K_OFF + cur * K_BYTES + r * QP + hh * 16;
        const LAS unsigned char* vb = lds + V_OFF + vcur * V_BYTES + r * VP + hh * 16;
#pragma unroll
        for (int half = 0; half < 2; ++half) {
            if (lag) PVH(Pc, vold);
            QKEXP(Pc, half);
            if (half == 0 && pf) { *(LAS u32x4*)(lds + V_OFF + vnx * V_BYTES + vrow0 * VP + vc * 16) = sg0; *(LAS u32x4*)(lds + V_OFF + vnx * V_BYTES + (vrow0 + 64) * VP + vc * 16) = sg1;
                if (kt + 2 < nkt) { sg0 = *(const u32x4*)(kg + (ko + 64 + krow0) * 1024 + kc * 8); sg1 = *(const u32x4*)(kg + (ko + 64 + krow0 + 32) * 1024 + kc * 8); } }
            vold = vb + half * 64;
            SB0();
            if (!lag) PVH(Pc, vold);
        }
        __syncthreads();
        vcur = vnx;
    }
    if (lag) PVH(Pc, vold);
#undef QKEXP
#undef PVH
#undef SB0
    const float l0 = lsum[0] + __shfl_xor(lsum[0], 32), l1 = lsum[1] + __shfl_xor(lsum[1], 32);
    const float i0 = 1.f / l0, c1 = lam / l1;
    float ss = 0.f;
#pragma unroll
    for (int mt = 0; mt < 4; ++mt)
#pragma unroll
        for (int i = 0; i < 16; ++i) { const float o = OT[0][mt][i] * i0 - OT[1][mt][i] * c1; OT[0][mt][i] = o; ss += o * o; }
    ss += __shfl_xor(ss, 32);
    int lib = lam_init_bits; asm volatile("" : "+s"(lib));
    const float rs = rsqrtf(ss * (1.f / 128.f) + EPS) * (1.f - __builtin_bit_cast(float, lib));
    LAS unsigned char* stg = lds + Q_OFF + (32 * wid) * QP;
#pragma unroll
    for (int mt = 0; mt < 4; ++mt)
#pragma unroll
        for (int g = 0; g < 4; ++g) { const int dv0 = 32 * mt + 8 * g + 4 * hh; const f32x4 gv = *(const f32x4*)(subln_g + dv0);
            u32x2 w; w.x = pk2(OT[0][mt][4 * g] * rs * gv[0], OT[0][mt][4 * g + 1] * rs * gv[1]); w.y = pk2(OT[0][mt][4 * g + 2] * rs * gv[2], OT[0][mt][4 * g + 3] * rs * gv[3]);
            *(LAS u32x2*)(stg + r * QP + dv0 * 2) = w; }
    LDS_WAIT();
#pragma unroll
    for (int i = 0; i < 8; ++i) { const int id = i * 64 + lane, row = id >> 4, c = id & 15;
        const u32x4 v = *(const LAS u32x4*)(stg + row * QP + c * 16);
        *(u32x4*)(concat + (rowbase + q0 + 32 * wid + row) * DM + h * 128 + c * 8) = v; }
    __syncthreads();
}
}

struct Params { const float* in[20]; float* out; unsigned char* ws; int ph_lo, ph_hi, coop, pad; };
enum { I_X = 0, I_C, I_CTX, I_CCTX, I_WMOD, I_BMOD, I_N1G, I_N2G, I_WIN, I_QG, I_KG, I_LAM, I_SUBLN, I_WUP, I_BUP, I_GLAG, I_WF, I_WOUT, I_WFF1, I_WFF2 };

typedef const __attribute__((address_space(4))) Params* KParamsPtr;
DI KParamsPtr KP() { KParamsPtr q = (KParamsPtr)__builtin_amdgcn_kernarg_segment_ptr(); asm volatile("" : "+s"(q)); return q; }
#define PRM (*KP())

DI void tr_item(const float* W, int ldw, int k0, int srcc0, bf16_t* WT, int K, int dstr0, LAS float* scr, int lane) {
#pragma unroll
    for (int i = 0; i < 32; ++i) { const int kk = 2 * i + (lane >> 5); scr[kk * 33 + (lane & 31)] = srcc0 >= 0 ? W[(size_t)(k0 + kk) * ldw + srcc0 + (lane & 31)] : 0.f; }
    LDS_WAIT();
    const int c = lane & 7;
#pragma unroll
    for (int j = 0; j < 4; ++j) { const int n = (lane >> 3) + 8 * j; const LAS float* s = scr + (8 * c) * 33 + n;
        u32x4 o; o.x = pk2(s[0 * 33], s[1 * 33]); o.y = pk2(s[2 * 33], s[3 * 33]); o.z = pk2(s[4 * 33], s[5 * 33]); o.w = pk2(s[6 * 33], s[7 * 33]);
        *(u32x4*)(WT + (size_t)(dstr0 + n) * K + k0 + 8 * c) = o; }
    LDS_WAIT();
}
DI int win_src_col(int n0) {
    if (n0 < 3072 + 1536) return n0;
    if (n0 < 3072 + 2048) return 4640 + (n0 - 4608);
    if (n0 < 3072 + 2080) return 4608 + (n0 - 5120);
    return -1;
}

DI void phase_prep(LAS unsigned char* lds, int l) {
    const int tid = TID(), wid = tid >> 6, lane = tid & 63, G = GDIM(), bx = BID();
    unsigned char* ws = LP(PRM.ws);
    LAS float* tab = (LAS float*)lds;
    for (int m = tid; m < 8192; m += 512) tab[m] = __cosf((float)m * (6.283185307179586f / 8192.f));
    __syncthreads();
    {
        bf16_t* A1 = (bf16_t*)(ws + WS_A1); bf16_t* A2 = (bf16_t*)(ws + WS_A2);
        for (int idx = bx * 512 + tid; idx < 2 * 256 * 128; idx += G * 512) {
            const int which = idx >> 15, m = (idx >> 7) & 255, k = idx & 127; float v;
            if (which == 0) { const int c = m & 127; const float cs = tab[(unsigned)(k * c * 64) & 8191u], sn = tab[((unsigned)(k * c * 64) + 8192u - 2048u) & 8191u]; v = (m < 128 ? cs : -sn) * (1.f / 1024.f); A1[m * 128 + k] = (bf16_t)f2bf(v); }
            else { const int d = m & 63, bb = k & 63; const float cs = tab[(unsigned)(bb * d * 128) & 8191u], sn = tab[((unsigned)(bb * d * 128) + 8192u - 2048u) & 8191u];
                if (m < 64) v = k < 64 ? cs : sn; else if (m < 128) v = k < 64 ? sn : -cs; else v = 0.f;
                A2[m * 128 + k] = (bf16_t)f2bf(v); } }
        if (l == 0) {
            bf16_t* Tc = (bf16_t*)(ws + WS_TCTX);
            for (int id = bx * 512 + tid; id < 512 * 32; id += G * 512) {
                const int rr = id >> 5, n0 = (id & 31) * 8; const bool sp = rr >= 256; const unsigned k1 = sp ? rr - 256 : rr; const unsigned sh = sp ? 8192u - 2048u : 0u;
                float v[8];
#pragma unroll
                for (int j = 0; j < 8; ++j) v[j] = tab[(k1 * (unsigned)(n0 + j) * 32u + sh) & 8191u] * 0.005524271728019903f;
                u32x4 o; o.x = pk2(v[0], v[1]); o.y = pk2(v[2], v[3]); o.z = pk2(v[4], v[5]); o.w = pk2(v[6], v[7]);
                *(u32x4*)(Tc + (size_t)id * 8) = o; } }
        const float* wf = PRM.in[I_WF] + (size_t)l * 512 * 512; bf16_t* Wcs = (bf16_t*)(ws + WS_WCS);
        for (int idx = bx * 512 + tid; idx < 512 * 1024; idx += G * 512) {
            const int j = idx & 511, kk = idx >> 9; const bool sp = kk >= 512; const int k2i = kk & 511, g = k2i >> 7, n2 = k2i & 127; const unsigned sh = sp ? 8192u - 2048u : 0u;
            float acc = 0.f;
#pragma unroll 16
            for (int k2 = 0; k2 < 128; ++k2) acc += tab[((unsigned)((k2 * n2) & 127) * 64u + sh) & 8191u] * wf[(size_t)(g * 128 + k2) * 512 + j];
            Wcs[(size_t)j * 1024 + kk] = (bf16_t)f2bf(sp ? -acc : acc); }
    }
    {
        LAS float* scr = (LAS float*)(lds + 32768 + wid * 8448);
        const int gw = bx * 8 + wid, NGW = G * 8;
        constexpr int I_IN = 32 * (NIN / 32), I_OUT = 32 * 64, I_F1 = 32 * 256, I_F2 = 128 * 64;
        const float* win = PRM.in[I_WIN] + (size_t)l * DM * DIN; const float* wout = PRM.in[I_WOUT] + (size_t)l * DM * DM;
        const float* wf1 = PRM.in[I_WFF1] + (size_t)l * DM * DFF; const float* wf2 = PRM.in[I_WFF2] + (size_t)l * DFF * DM;
        for (int it = gw; it < I_IN + I_OUT + I_F1 + I_F2; it += NGW) {
            int r = it;
            if (r < I_IN) { const int nb = r % (NIN / 32), kb = r / (NIN / 32); tr_item(win, DIN, kb * 64, win_src_col(nb * 32), (bf16_t*)(ws + WS_WIN), DM, nb * 32, scr, lane); continue; } r -= I_IN;
            if (r < I_OUT) { const int nb = r % 64, kb = r / 64; tr_item(wout, DM, kb * 64, nb * 32, (bf16_t*)(ws + WS_WOUT), DM, nb * 32, scr, lane); continue; } r -= I_OUT;
            if (r < I_F1) { const int nb = r % 256, kb = r / 256; tr_item(wf1, DFF, kb * 64, nb * 32, (bf16_t*)(ws + WS_WFF1), DM, nb * 32, scr, lane); continue; } r -= I_F1;
            { const int nb = r % 64, kb = r / 64; tr_item(wf2, DM, kb * 64, nb * 32, (bf16_t*)(ws + WS_WFF2), DFF, nb * 32, scr, lane); }
        }
    }
    __syncthreads();
    if (l == 0) {
        LAS float* sv = (LAS float*)lds;
        LAS float* red = (LAS float*)(lds + 24576);
        for (int i = tid; i < 3 * 2048; i += 512) { const int s = i >> 11, k = i & 2047; const float c = s < 2 ? PRM.in[I_C][s * 2048 + k] : PRM.in[I_CCTX][k]; sv[i] = c / (1.f + __expf(-c)); }
        __syncthreads();
        float* mod = (float*)(ws + WS_MOD);
        const int cl = tid & 15, ks = tid >> 4;
        for (int item = bx; item < 2 * 192; item += G) {
            const int l2 = item / 192, j0 = (item % 192) * 64;
            const float* wm = PRM.in[I_WMOD] + ((size_t)l2 * 2048 + ks * 64) * 12288 + j0 + cl * 4;
            f32x4 a0 = {0.f, 0.f, 0.f, 0.f}, a1 = a0, a2 = a0;
#pragma unroll 8
            for (int kk = 0; kk < 64; ++kk) { const f32x4 w = *(const f32x4*)(wm + (size_t)kk * 12288); const int k = ks * 64 + kk;
                a0 += w * sv[k]; a1 += w * sv[2048 + k]; a2 += w * sv[4096 + k]; }
#pragma unroll
            for (int i = 0; i < 4; ++i) { red[(ks * 3 + 0) * 64 + cl * 4 + i] = a0[i]; red[(ks * 3 + 1) * 64 + cl * 4 + i] = a1[i]; red[(ks * 3 + 2) * 64 + cl * 4 + i] = a2[i]; }
            __syncthreads();
            if (tid < 192) { const int s = tid >> 6, ci = tid & 63; float t = PRM.in[I_BMOD][(size_t)l2 * 12288 + j0 + ci];
                for (int k2 = 0; k2 < 32; ++k2) t += red[(k2 * 3 + s) * 64 + ci];
                mod[((size_t)l2 * 3 + s) * 12288 + j0 + ci] = t; }
            __syncthreads();
        }
    }
}

DI const float* hrow_in(int l, int b, int t) {
    if (l == 0) return t < CTXL ? PRM.in[I_CTX] + ((size_t)b * CTXL + t) * DM : PRM.in[I_X] + ((size_t)b * SEQ + (t - CTXL)) * DM;
    return t < CTXL ? (const float*)(LP(PRM.ws) + WS_XC) + ((size_t)b * CTXL + t) * DM : PRM.out + ((size_t)b * SEQ + (t - CTXL)) * DM;
}
DI void phase_norm(int l, int stage, bool skipctx, int fold, int gate_l, int gate_chunk, const void* latsrc, int lat_bf16) {
    const int tid = TID(), wid = tid >> 6, lane = tid & 63;
    const float* mod = (const float*)(LP(PRM.ws) + WS_MOD); bf16_t* A = (bf16_t*)(LP(PRM.ws) + WS_A);
    const float* gvec = PRM.in[stage == 0 ? I_N1G : I_N2G] + (size_t)l * DM;
    f32x4 ggv[8], shv[8]; int cur_s = -1;
    for (int row = BID() * 8 + wid; row < MROWS; row += GDIM() * 8) {
        const int b = row / TPB, t = row % TPB; const bool isctx = t < CTXL;
        if (skipctx && isctx) continue;
        const int ssel = isctx ? 2 : b;
        if (ssel != cur_s) { cur_s = ssel;
            const float* sh = mod + ((size_t)l * 3 + ssel) * 12288 + (size_t)(stage * 3) * DM; const float* sc = sh + DM;
#pragma unroll
            for (int j = 0; j < 8; ++j) { const int c = 4 * (64 * j + lane); ggv[j] = *(const f32x4*)(gvec + c) * (*(const f32x4*)(sc + c) + 1.f); shv[j] = *(const f32x4*)(sh + c); } }
        const float* src = hrow_in(stage == 0 ? l : 1, b, t);
        if (isctx && fold == 1) src = PRM.in[I_CTX] + ((size_t)b * CTXL + t) * DM;
        f32x4 v[8]; float ss = 0.f;
        if (!isctx && lat_bf16) { const bf16_t* sb_ = (const bf16_t*)latsrc + ((size_t)b * SEQ + (t - CTXL)) * DM;
#pragma unroll
            for (int j = 0; j < 8; ++j) { const u32x2 w = *((const u32x2*)sb_ + 64 * j + lane); v[j] = (f32x4){bf2f(w.x & 0xffff), bf2f(w.x >> 16), bf2f(w.y & 0xffff), bf2f(w.y >> 16)}; } }
        else { if (!isctx) src = (const float*)latsrc + ((size_t)b * SEQ + (t - CTXL)) * DM;
#pragma unroll
            for (int j = 0; j < 8; ++j) v[j] = *((const f32x4*)src + 64 * j + lane); }
        if (isctx && fold) {
            const float* part = (const float*)(LP(PRM.ws) + WS_PART) + ((size_t)b * CTXL + t) * DM; const float* gt = mod + ((size_t)gate_l * 3 + 2) * 12288 + (size_t)gate_chunk * DM;
            float* xc = (float*)(LP(PRM.ws) + WS_XC) + ((size_t)b * CTXL + t) * DM;
#pragma unroll
            for (int j = 0; j < 8; ++j) { f32x4 a = *((const f32x4*)part + 64 * j + lane);
#pragma unroll
                for (int k = 1; k < NSPLIT; ++k) a += *((const f32x4*)(part + (size_t)k * 512 * DM) + 64 * j + lane);
                v[j] += a * *((const f32x4*)gt + 64 * j + lane); *((f32x4*)xc + 64 * j + lane) = v[j]; }
        }
#pragma unroll
        for (int j = 0; j < 8; ++j) ss += (v[j][0] * v[j][0] + v[j][1] * v[j][1]) + (v[j][2] * v[j][2] + v[j][3] * v[j][3]);
        const float rs = rsqrtf(wave_sum(ss) * (1.f / DM) + EPS);
#pragma unroll
        for (int j = 0; j < 8; ++j) { const int c = 4 * (64 * j + lane);
            const f32x4 y = v[j] * rs * ggv[j] + shv[j];
            u32x2 w; w.x = pk2(y[0], y[1]); w.y = pk2(y[2], y[3]); *(u32x2*)(A + (size_t)row * DM + c) = w; }
    }
}

DI void tr_unit(LAS unsigned char* lds, const bf16_t* src, int ld, bf16_t* dst, size_t dpitch, bool perm) {
    const int tid = TID();
#pragma unroll
    for (int i = 0; i < 2; ++i) { const int id = i * 512 + tid, row = id >> 4, c = id & 15;
        *(LAS u32x4*)(lds + row * 272 + c * 16) = *(const u32x4*)(src + (size_t)row * ld + c * 8); }
    __syncthreads();
#pragma unroll
    for (int i = 0; i < 2; ++i) { const int id = i * 512 + tid, j = id >> 3, c = id & 7; unsigned e[8];
#pragma unroll
        for (int q = 0; q < 8; ++q) { const int key = perm ? (16 * (c >> 1) + 8 * (q >> 2) + 4 * (c & 1) + (q & 3)) : (8 * c + q); e[q] = *(const LAS unsigned short*)(lds + key * 272 + j * 2); }
        u32x4 o; o.x = e[0] | (e[1] << 16); o.y = e[2] | (e[3] << 16); o.z = e[4] | (e[5] << 16); o.w = e[6] | (e[7] << 16);
        *(u32x4*)(dst + (size_t)j * dpitch + c * 8) = o; }
    __syncthreads();
}

DI void gla_load(LAS unsigned char* lds, int l, int b, int h, int c, int off_q  , int off_k, int off_v, int off_pa, int off_wup, int off_bup) {
    const int tid = TID();
    const bf16_t* P2 = (const bf16_t*)(LP(PRM.ws) + WS_P2) + ((size_t)b * TPB + (size_t)c * 64) * P2W;
    { const int row = tid >> 3, c8 = tid & 7;
      const u32x4 kv = *(const u32x4*)(P2 + (size_t)row * P2W + 256 + h * 64 + c8 * 8); LAS float* kd = (LAS float*)(lds + off_k) + row * 64 + c8 * 8;
      kd[0] = bf2f(kv.x & 0xffff); kd[1] = bf2f(kv.x >> 16); kd[2] = bf2f(kv.y & 0xffff); kd[3] = bf2f(kv.y >> 16); kd[4] = bf2f(kv.z & 0xffff); kd[5] = bf2f(kv.z >> 16); kd[6] = bf2f(kv.w & 0xffff); kd[7] = bf2f(kv.w >> 16);
      if (off_q >= 0) { const u32x4 qv = *(const u32x4*)(P2 + (size_t)row * P2W + h * 64 + c8 * 8); LAS float* qd = (LAS float*)(lds + off_q) + row * 64 + c8 * 8;
        qd[0] = bf2f(qv.x & 0xffff); qd[1] = bf2f(qv.x >> 16); qd[2] = bf2f(qv.y & 0xffff); qd[3] = bf2f(qv.y >> 16); qd[4] = bf2f(qv.z & 0xffff); qd[5] = bf2f(qv.z >> 16); qd[6] = bf2f(qv.w & 0xffff); qd[7] = bf2f(qv.w >> 16); } }
#pragma unroll
    for (int i = 0; i < 2; ++i) { const int id = i * 512 + tid, row = id >> 4, c8 = id & 15;
        const u32x4 vv = *(const u32x4*)(P2 + (size_t)row * P2W + 512 + h * 128 + c8 * 8); LAS float* vd = (LAS float*)(lds + off_v) + row * 128 + c8 * 8;
        vd[0] = bf2f(vv.x & 0xffff); vd[1] = bf2f(vv.x >> 16); vd[2] = bf2f(vv.y & 0xffff); vd[3] = bf2f(vv.y >> 16); vd[4] = bf2f(vv.z & 0xffff); vd[5] = bf2f(vv.z >> 16); vd[6] = bf2f(vv.w & 0xffff); vd[7] = bf2f(vv.w >> 16); }
    if (tid < 256) { const int row = tid >> 2, c8 = tid & 3;
        const u32x4 pv = *(const u32x4*)(P2 + (size_t)row * P2W + 2048 + c8 * 8); LAS float* pd = (LAS float*)(lds + off_pa) + row * 32 + c8 * 8;
        pd[0] = bf2f(pv.x & 0xffff); pd[1] = bf2f(pv.x >> 16); pd[2] = bf2f(pv.y & 0xffff); pd[3] = bf2f(pv.y >> 16); pd[4] = bf2f(pv.z & 0xffff); pd[5] = bf2f(pv.z >> 16); pd[6] = bf2f(pv.w & 0xffff); pd[7] = bf2f(pv.w >> 16); }
#pragma unroll
    for (int i = 0; i < 4; ++i) { const int idx = tid * 4 + i, d = idx >> 10, rr = (idx >> 6) & 15, dk = idx & 63;
        ((LAS float*)(lds + off_wup))[idx] = PRM.in[I_WUP][((size_t)(l * 2 + d) * 16 + rr) * 256 + h * 64 + dk]; }
    if (tid < 128) { const int d = tid >> 6, dk = tid & 63; ((LAS float*)(lds + off_bup))[tid] = PRM.in[I_BUP][(size_t)(l * 2 + d) * 256 + h * 64 + dk]; }
}
DI float gla_cumsum(const LAS float* paf, const LAS float* wup, const LAS float* bup, int d, int dk, LAS float* out) {
    float w[16];
#pragma unroll
    for (int rr = 0; rr < 16; ++rr) w[rr] = wup[(d * 16 + rr) * 64 + dk];
    const float bb = bup[d * 64 + dk];
    float run = 0.f;
    for (int s = 0; s < 64; ++s) { const int t = d ? 63 - s : s; float z = bb;
#pragma unroll
        for (int rr = 0; rr < 16; ++rr) z += paf[t * 32 + d * 16 + rr] * w[rr];
        run += logsig(z) * (1.f / 16.f); out[t * 64 + dk] = run; }
    return run;
}
DI float gla_cumsum_par(LAS float* buf, LAS float* seg, int tid) {
    const int col = tid & 127, d = col >> 6, dk = col & 63, sg = tid >> 7;
    LAS float* p = buf + d * 4096 + dk;
    float v[16]; float run = 0.f;
#pragma unroll
    for (int i = 0; i < 16; ++i) { const int sp = sg * 16 + i, t = d ? 63 - sp : sp; run += p[t * 64]; v[i] = run; }
    seg[sg * 128 + col] = run;
    __syncthreads();
    const float s0 = seg[col], s1 = seg[128 + col], s2 = seg[256 + col], s3 = seg[384 + col];
    const float pre = sg == 0 ? 0.f : sg == 1 ? s0 : sg == 2 ? s0 + s1 : s0 + s1 + s2;
#pragma unroll
    for (int i = 0; i < 16; ++i) { const int sp = sg * 16 + i, t = d ? 63 - sp : sp; p[t * 64] = v[i] + pre; }
    return (s0 + s1) + (s2 + s3);
}
DI void gla_g1_unit(LAS unsigned char* lds, int l, int b, int h, int c) {
    constexpr int OK = 0, OV = 16384, OPA = 49152, OWUP = 57344, OBUP = 65536, OE = 66560;
    const int tid = TID();
    gla_load(lds, l, b, h, c, -1, OK, OV, OPA, OWUP, OBUP);
    __syncthreads();
    const LAS float* kf = (const LAS float*)(lds + OK); const LAS float* vf = (const LAS float*)(lds + OV);
    LAS float* E = (LAS float*)(lds + OE);
    bf16_t* KV = (bf16_t*)(LP(PRM.ws) + WS_KV); float* DEC = (float*)(LP(PRM.ws) + WS_DEC);
    {
        const LAS float* paf = (const LAS float*)(lds + OPA); const LAS float* wup = (const LAS float*)(lds + OWUP); const LAS float* bup = (const LAS float*)(lds + OBUP);
        LAS float* bl_s = (LAS float*)(lds + OE + 32768);
        const int dk = tid & 63;
#pragma unroll
        for (int d = 0; d < 2; ++d) { float w[16];
#pragma unroll
            for (int rr = 0; rr < 16; ++rr) w[rr] = wup[(d * 16 + rr) * 64 + dk];
            const float bb = bup[d * 64 + dk];
            for (int t = tid >> 6; t < 64; t += 8) { float z = bb;
#pragma unroll
                for (int rr = 0; rr < 16; ++rr) z += paf[t * 32 + d * 16 + rr] * w[rr];
                E[d * 4096 + t * 64 + dk] = logsig(z) * (1.f / 16.f); } }
        __syncthreads();
        { const float tot = gla_cumsum_par(E, (LAS float*)(lds + OE + 32768 + 512), tid);
          if (tid < 128) { const int d = tid >> 6; bl_s[d * 64 + dk] = tot; DEC[((size_t)((b * 2 + d) * 4 + h) * NCH + c) * 64 + dk] = __expf(tot); } }
        __syncthreads();
#pragma unroll
        for (int i = 0; i < 16; ++i) { const int idx = i * 512 + tid, d = idx >> 12, td = idx & 4095; E[idx] = __expf(bl_s[d * 64 + (td & 63)] - E[idx]) * kf[td]; }
    }
    __syncthreads();
    { const int d = tid >> 8, tt = tid & 255, dvq = tt & 31, dkq = tt >> 5; const LAS float* Ed = E + d * 4096;
      f32x4 acc[8];
#pragma unroll
      for (int i = 0; i < 8; ++i) acc[i] = (f32x4){0.f, 0.f, 0.f, 0.f};
      for (int t = 0; t < 64; ++t) { const f32x4 vv = *(const LAS f32x4*)(vf + t * 128 + 4 * dvq);
#pragma unroll
          for (int i = 0; i < 8; ++i) acc[i] += vv * Ed[t * 64 + dkq * 8 + i]; }
      bf16_t* dst = KV + ((size_t)((b * 2 + d) * 4 + h) * NCH + c) * 8192;
#pragma unroll
      for (int i = 0; i < 8; ++i) { u32x2 w; w.x = pk2(acc[i][0], acc[i][1]); w.y = pk2(acc[i][2], acc[i][3]); *(u32x2*)(dst + (dkq * 8 + i) * 128 + 4 * dvq) = w; } }
    __syncthreads();
}
DI void gla_scan() {
    const int tid = TID(); unsigned* KV = (unsigned*)(LP(PRM.ws) + WS_KV); const float* DEC = (const float*)(LP(PRM.ws) + WS_DEC);
    for (int item = BID(); item < 128; item += GDIM()) {
        const int seq = item >> 3, slab = item & 7, d = (seq >> 2) & 1, e2 = slab * 512 + tid  , dk = e2 >> 6;
        float S0 = 0.f, S1 = 0.f;
        for (int s0 = 0; s0 < NCH; s0 += 33) { unsigned kvv[33]; float dc[33];
#pragma unroll
            for (int j = 0; j < 33; ++j) { const int st = s0 + j, c = d ? (st < 4 ? 3 - st : 135 - st) : st; kvv[j] = KV[((size_t)seq * NCH + c) * 4096 + e2]; dc[j] = DEC[((size_t)seq * NCH + c) * 64 + dk]; }
#pragma unroll
            for (int j = 0; j < 33; ++j) { const int st = s0 + j, c = d ? (st < 4 ? 3 - st : 135 - st) : st; KV[((size_t)seq * NCH + c) * 4096 + e2] = pk2(S0, S1);
                S0 = dc[j] * S0 + bf2f(kvv[j] & 0xffff); S1 = dc[j] * S1 + bf2f(kvv[j] >> 16); } }
    }
}
DI void gla_g3_unit(LAS unsigned char* lds, int l, int b, int h, int c) {
    constexpr int OQ = 0, OK = 16384, OPA = 32768, OWUP = 40960, OBUP = 49152, OG = 50176, OVT = 82944, OQE = 101376, OKE = 110592, OST = 119808, OOT = 0, PB = 144;
    const int tid = TID(), wid = __builtin_amdgcn_readfirstlane(tid >> 6), lane = tid & 63, r = lane & 31, hh = lane >> 5;
    const bf16_t* P2 = (const bf16_t*)(LP(PRM.ws) + WS_P2) + ((size_t)b * TPB + (size_t)c * 64) * P2W;
    {
        const int row = tid >> 3, c8 = tid & 7;
        const u32x4 kv = *(const u32x4*)(P2 + (size_t)row * P2W + 256 + h * 64 + c8 * 8); LAS float* kd = (LAS float*)(lds + OK) + row * 64 + c8 * 8;
        kd[0] = bf2f(kv.x & 0xffff); kd[1] = bf2f(kv.x >> 16); kd[2] = bf2f(kv.y & 0xffff); kd[3] = bf2f(kv.y >> 16); kd[4] = bf2f(kv.z & 0xffff); kd[5] = bf2f(kv.z >> 16); kd[6] = bf2f(kv.w & 0xffff); kd[7] = bf2f(kv.w >> 16);
        const u32x4 qv = *(const u32x4*)(P2 + (size_t)row * P2W + h * 64 + c8 * 8); LAS float* qd = (LAS float*)(lds + OQ) + row * 64 + c8 * 8;
        qd[0] = bf2f(qv.x & 0xffff); qd[1] = bf2f(qv.x >> 16); qd[2] = bf2f(qv.y & 0xffff); qd[3] = bf2f(qv.y >> 16); qd[4] = bf2f(qv.z & 0xffff); qd[5] = bf2f(qv.z >> 16); qd[6] = bf2f(qv.w & 0xffff); qd[7] = bf2f(qv.w >> 16);
#pragma unroll
        for (int i = 0; i < 2; ++i) { const int id = i * 512 + tid, m = id >> 4, cc = id & 15;
            const u32x4 vv = *(const u32x4*)(P2 + (size_t)m * P2W + 512 + h * 128 + cc * 8);
            const int m16 = m & 15, pos = (m & ~15) + 8 * ((m16 >> 2) & 1) + ((m16 >> 3) << 2) + (m16 & 3);
            LAS unsigned short* vt = (LAS unsigned short*)(lds + OVT + (cc * 8) * PB + pos * 2);
            vt[0 * (PB / 2)] = vv.x & 0xffff; vt[1 * (PB / 2)] = vv.x >> 16; vt[2 * (PB / 2)] = vv.y & 0xffff; vt[3 * (PB / 2)] = vv.y >> 16;
            vt[4 * (PB / 2)] = vv.z & 0xffff; vt[5 * (PB / 2)] = vv.z >> 16; vt[6 * (PB / 2)] = vv.w & 0xffff; vt[7 * (PB / 2)] = vv.w >> 16; }
        if (tid < 256) { const int prow = tid >> 2, p8 = tid & 3;
            const u32x4 pv = *(const u32x4*)(P2 + (size_t)prow * P2W + 2048 + p8 * 8); LAS float* pd = (LAS float*)(lds + OPA) + prow * 32 + p8 * 8;
            pd[0] = bf2f(pv.x & 0xffff); pd[1] = bf2f(pv.x >> 16); pd[2] = bf2f(pv.y & 0xffff); pd[3] = bf2f(pv.y >> 16); pd[4] = bf2f(pv.z & 0xffff); pd[5] = bf2f(pv.z >> 16); pd[6] = bf2f(pv.w & 0xffff); pd[7] = bf2f(pv.w >> 16); }
#pragma unroll
        for (int i = 0; i < 4; ++i) { const int idx = tid * 4 + i, d = idx >> 10, rr = (idx >> 6) & 15, dk = idx & 63;
            ((LAS float*)(lds + OWUP))[idx] = PRM.in[I_WUP][((size_t)(l * 2 + d) * 16 + rr) * 256 + h * 64 + dk]; }
        if (tid < 128) { const int d = tid >> 6, dk = tid & 63; ((LAS float*)(lds + OBUP))[tid] = PRM.in[I_BUP][(size_t)(l * 2 + d) * 256 + h * 64 + dk]; }
    }
    const bf16_t* KVp = (const bf16_t*)(LP(PRM.ws) + WS_KV);
    u32x4 sS[2][2]; u32x2 rG[4];
#pragma unroll
    for (int d = 0; d < 2; ++d) { const bf16_t* Sg = KVp + ((size_t)((b * 2 + d) * 4 + h) * NCH + c) * 8192;
#pragma unroll
        for (int i = 0; i < 2; ++i) { const int id = i * 512 + tid; sS[d][i] = *(const u32x4*)(Sg + (id >> 4) * 128 + (id & 15) * 8); } }
#pragma unroll
    for (int i = 0; i < 4; ++i) rG[i] = *(const u32x2*)(P2 + (size_t)(4 * (tid >> 5) + i) * P2W + 1024 + h * 128 + 4 * (tid & 31));
    __syncthreads();
    const LAS float* qf = (const LAS float*)(lds + OQ); const LAS float* kf = (const LAS float*)(lds + OK);
    const LAS float* paf = (const LAS float*)(lds + OPA); const LAS float* wup = (const LAS float*)(lds + OWUP); const LAS float* bup = (const LAS float*)(lds + OBUP);
    LAS float* gl = (LAS float*)(lds + OG);
    {
        const int dk = tid & 63;
#pragma unroll
        for (int d = 0; d < 2; ++d) { float w[16];
#pragma unroll
            for (int rr = 0; rr < 16; ++rr) w[rr] = wup[(d * 16 + rr) * 64 + dk];
            const float bb = bup[d * 64 + dk];
            for (int t = tid >> 6; t < 64; t += 8) { float z = bb;
#pragma unroll
                for (int rr = 0; rr < 16; ++rr) z += paf[t * 32 + d * 16 + rr] * w[rr];
                gl[d * 4096 + t * 64 + dk] = logsig(z) * (1.f / 16.f); } }
    }
    __syncthreads();
    (void)gla_cumsum_par(gl, (LAS float*)(lds + 138240), tid);
    __syncthreads();
    const int mt = wid & 3, ntl = wid >> 2;
    f32x16 acc;
#pragma unroll
    for (int i = 0; i < 16; ++i) acc[i] = 0.f;
    const bf16_t* KV = (const bf16_t*)(LP(PRM.ws) + WS_KV);
    for (int d = 0; d < 2; ++d) {
        {
#pragma unroll
            for (int i = 0; i < 4; ++i) { const int idx2 = (i * 512 + tid) * 2, t = idx2 >> 6, dk = idx2 & 63;
                const float b0 = gl[d * 4096 + idx2], b1 = gl[d * 4096 + idx2 + 1];
                *(LAS unsigned*)(lds + OQE + t * PB + dk * 2) = pk2(qf[idx2] * __expf(b0) * 0.125f, qf[idx2 + 1] * __expf(b1) * 0.125f);
                *(LAS unsigned*)(lds + OKE + t * PB + dk * 2) = pk2(kf[idx2] * __expf(-b0), kf[idx2 + 1] * __expf(-b1)); }
#pragma unroll
            for (int i = 0; i < 2; ++i) { const int id = i * 512 + tid, dk = id >> 4, dv8 = (id & 15) * 8; const u32x4 sv = d ? sS[1][i] : sS[0][i];
                LAS unsigned short* st = (LAS unsigned short*)(lds + OST + dv8 * PB + dk * 2);
                st[0] = sv.x & 0xffff; st[PB / 2] = sv.x >> 16; st[2 * (PB / 2)] = sv.y & 0xffff; st[3 * (PB / 2)] = sv.y >> 16;
                st[4 * (PB / 2)] = sv.z & 0xffff; st[5 * (PB / 2)] = sv.z >> 16; st[6 * (PB / 2)] = sv.w & 0xffff; st[7 * (PB / 2)] = sv.w >> 16; }
        }
        __syncthreads();
        {
            bf16x8 qfr[4];
#pragma unroll
            for (int s = 0; s < 4; ++s) qfr[s] = *(const LAS bf16x8*)(lds + OQE + (32 * ntl + r) * PB + s * 32 + hh * 16);
#pragma unroll
            for (int s = 0; s < 4; ++s) { const bf16x8 sf = *(const LAS bf16x8*)(lds + OST + (32 * mt + r) * PB + s * 32 + hh * 16); acc = MFMA32(sf, qfr[s], acc); }
#pragma unroll
            for (int j = 0; j < 2; ++j) {
                f32x16 at;
#pragma unroll
                for (int i = 0; i < 16; ++i) at[i] = 0.f;
#pragma unroll
                for (int s = 0; s < 4; ++s) { const bf16x8 kfr = *(const LAS bf16x8*)(lds + OKE + (32 * j + r) * PB + s * 32 + hh * 16); at = MFMA32(kfr, qfr[s], at); }
                const int tcol = 32 * ntl + r;
#pragma unroll
                for (int i = 0; i < 16; ++i) { const int m = 32 * j + (i & 3) + 8 * (i >> 2) + 4 * hh; const bool keep = d ? (m >= tcol) : (m <= tcol); at[i] = keep ? at[i] : 0.f; }
#pragma unroll
                for (int s = 0; s < 2; ++s) {
                    const bf16x8 pf = att::pack8(at[8 * s], at[8 * s + 1], at[8 * s + 2], at[8 * s + 3], at[8 * s + 4], at[8 * s + 5], at[8 * s + 6], at[8 * s + 7]);
                    const bf16x8 vfr = *(const LAS bf16x8*)(lds + OVT + (32 * mt + r) * PB + (2 * j + s) * 32 + hh * 16);
                    acc = MFMA32(vfr, pf, acc); }
            }
        }
        __syncthreads();
    }
    {
        LAS float* oT = (LAS float*)(lds + OOT);
        const int t = 32 * ntl + r;
#pragma unroll
        for (int i = 0; i < 16; ++i) { const int dv = 32 * mt + (i & 3) + 8 * (i >> 2) + 4 * hh; oT[t * 132 + dv] = acc[i]; }
    }
    __syncthreads();
    const int tq = tid >> 5, dvq = tid & 31;
    const f32x4 gg = *(const f32x4*)(PRM.in[I_GLAG] + (size_t)l * 128 + 4 * dvq);
    bf16_t* concat = (bf16_t*)(LP(PRM.ws) + WS_A);
#pragma unroll
    for (int i = 0; i < 4; ++i) { const f32x4 o = *(const LAS f32x4*)(lds + OOT + ((4 * tq + i) * 132 + 4 * dvq) * 4);
        float ss = (o[0] * o[0] + o[1] * o[1]) + (o[2] * o[2] + o[3] * o[3]);
#pragma unroll
        for (int s = 1; s < 32; s <<= 1) ss += __shfl_xor(ss, s);
        const float rs = rsqrtf(ss * (1.f / 128.f) + EPS);
        const size_t row = (size_t)c * 64 + 4 * tq + i;
        const u32x2 rv = rG[i];
        float r4[4] = {bf2f(rv.x & 0xffff), bf2f(rv.x >> 16), bf2f(rv.y & 0xffff), bf2f(rv.y >> 16)}; float y[4];
#pragma unroll
        for (int j = 0; j < 4; ++j) y[j] = o[j] * rs * gg[j] * (r4[j] / (1.f + __expf(-r4[j])));
        u32x2 w; w.x = pk2(y[0], y[1]); w.y = pk2(y[2], y[3]); *(u32x2*)(concat + ((size_t)b * TPB + row) * DM + 1024 + h * 128 + 4 * dvq) = w; }
    __syncthreads();
}

DI void phase_post(LAS unsigned char* lds, int l, bool do_qk) {
    const int tid = TID(), wid = tid >> 6, lane = tid & 63, G = GDIM(), bx = BID();
    unsigned char* ws = LP(PRM.ws);
    if (do_qk) {
        const int lp = lane & 31, d0 = 2 * lp, dd = d0 & 31, i0 = dd & 15; const bool axis = d0 >= 32; const float sgn = dd < 16 ? -1.f : 1.f;
        const float inv0 = exp2f(-(float)i0 * (13.287712379549449f / 16.f)), inv1 = exp2f(-(float)(i0 + 1) * (13.287712379549449f / 16.f));
        const float gq0 = PRM.in[I_QG][(size_t)l * 64 + d0], gq1 = PRM.in[I_QG][(size_t)l * 64 + d0 + 1], gk0 = PRM.in[I_KG][(size_t)l * 64 + d0], gk1 = PRM.in[I_KG][(size_t)l * 64 + d0 + 1];
        for (int row = bx * 8 + wid; row < MROWS; row += G * 8) {
            const int t = row % TPB; const bool isctx = t < CTXL; const int tl = t - CTXL;
            const float pos = (float)(axis ? (tl & 63) : (tl >> 6));
            float s0 = 0.f, c0 = 1.f, s1 = 0.f, c1 = 1.f;
            if (!isctx) { const float a0 = pos * inv0, a1 = pos * inv1; s0 = __sinf(a0); c0 = __cosf(a0); s1 = __sinf(a1); c1 = __cosf(a1); }
            for (int which = 0; which < 2; ++which) {
                bf16_t* base = (bf16_t*)(ws + (which ? WS_KB : WS_QB)) + (size_t)row * 1024;
                const float g0 = which ? gk0 : gq0, g1 = which ? gk1 : gq1;
                unsigned wv[8];
#pragma unroll
                for (int it = 0; it < 8; ++it) wv[it] = *(const unsigned*)(base + it * 128 + lane * 2);
#pragma unroll
                for (int it = 0; it < 8; ++it) { const unsigned w = wv[it];
                    const float x0 = bf2f(w & 0xffff), x1 = bf2f(w >> 16); float ss = x0 * x0 + x1 * x1;
#pragma unroll
                    for (int s = 1; s < 32; s <<= 1) ss += __shfl_xor(ss, s);
                    const float rs = rsqrtf(ss * (1.f / 64.f) + EPS); float y0 = x0 * rs * g0, y1 = x1 * rs * g1;
                    const float p0 = __shfl_xor(y0, 8), p1 = __shfl_xor(y1, 8);
                    if (!isctx) { y0 = y0 * c0 + sgn * p0 * s0; y1 = y1 * c1 + sgn * p1 * s1; }
                    if (which == 0) { y0 *= QSCALE; y1 *= QSCALE; }
                    wv[it] = pk2(y0, y1); }
#pragma unroll
                for (int it = 0; it < 8; ++it) *(unsigned*)(base + it * 128 + lane * 2) = wv[it];
            }
        }
    }
    for (int u = bx; u < NB * NCH * 8; u += G) { const int h = u & 7, kt = (u >> 3) % NCH, b = u / (8 * NCH);
        tr_unit(lds, (const bf16_t*)(ws + WS_VB) + ((size_t)b * TPB + (size_t)kt * 64) * 1024 + h * 128, 1024,
                (bf16_t*)(ws + WS_VT) + ((size_t)(b * 8 + h) * 128) * TPB + (size_t)kt * 64, TPB, true); }
    for (int u = bx; u < NB * 4 * 4; u += G) { const int cgp = u & 3, kt = (u >> 2) & 3, b = u >> 4;
        const bf16_t* src = (const bf16_t*)(ws + WS_P2) + ((size_t)b * TPB + (size_t)kt * 64) * P2W + 1536 + cgp * 128;
        tr_unit(lds, src, P2W, (bf16_t*)(ws + WS_UTC) + ((size_t)(b * 512 + cgp * 128)) * 256 + kt * 64, 256, false); }
    for (int u = bx; u < NB * 64 * 4; u += G) { const int cgp = u & 3, bb = (u >> 2) & 63, b = u >> 8;
        const bf16_t* src = (const bf16_t*)(ws + WS_P2) + ((size_t)b * TPB + CTXL + bb) * P2W + 1536 + cgp * 128;
        bf16_t* dst = (bf16_t*)(ws + WS_UTL) + ((size_t)(b * 512 + cgp * 128) * 64 + bb) * 128;
#pragma unroll
        for (int i = 0; i < 4; ++i) { const int id = i * 512 + tid, row = id >> 4, c = id & 15;
            *(LAS u32x4*)(lds + row * 272 + c * 16) = *(const u32x4*)(src + (size_t)row * 64 * P2W + c * 8); }
        __syncthreads();
#pragma unroll
        for (int i = 0; i < 4; ++i) { const int id = i * 512 + tid, j = id >> 4, c = id & 15; unsigned e[8];
#pragma unroll
            for (int q = 0; q < 8; ++q) e[q] = *(const LAS unsigned short*)(lds + (8 * c + q) * 272 + j * 2);
            u32x4 o; o.x = e[0] | (e[1] << 16); o.y = e[2] | (e[3] << 16); o.z = e[4] | (e[5] << 16); o.w = e[6] | (e[7] << 16);
            *(u32x4*)(dst + (size_t)j * 8192 + c * 8) = o; }
        __syncthreads(); }
    for (int u = bx; u < NB * 4 * NCH; u += G) { const int c = u % NCH, h = (u / NCH) & 3, b = u / (4 * NCH); gla_g1_unit(lds, l, b, h, c); }
}

#define XB_TMO      128
#define XB_XCNT(j)  (256  + 64 * (j))
#define XB_XSUB(j)  (1280 + 64 * (j))
#define XB_XGEN(j)  (2304 + 64 * (j))
#define XB_TOP      3328
#define XB_TOPGEN   3392
#define XCD_BAR_WORDS 3456
#define XB_SPIN_CAP (1u << 18)
DI unsigned xb_ld(unsigned* p)              { return __hip_atomic_load(p, __ATOMIC_RELAXED, __HIP_MEMORY_SCOPE_AGENT); }
DI unsigned xb_add(unsigned* p, unsigned v) { return __hip_atomic_fetch_add(p, v, __ATOMIC_RELAXED, __HIP_MEMORY_SCOPE_AGENT); }
DI unsigned xb_xcc_id() { return (unsigned)__builtin_amdgcn_s_getreg((3 << 11) | 20) & 0xFu; }
#define XB_SPIN(cond, bar) do { unsigned _sp = 0; while (cond) { __builtin_amdgcn_s_sleep(1); \
    if ((++_sp & 255u) == 0u) { if (xb_ld(&(bar)[XB_TMO])) break; if (_sp > XB_SPIN_CAP) { atomicAdd(&(bar)[XB_TMO], 1u); break; } } } } while (0)
struct XcdBarrier { unsigned* bar; unsigned x; volatile LAS unsigned* st; };
DI void xcd_barrier_post(unsigned* bar) { if (threadIdx.x == 0) (void)xb_add(&bar[XB_XCNT(xb_xcc_id())], 1u); }
DI void xcd_barrier_complete(unsigned* bar, unsigned x, unsigned& nloc, unsigned& nx) {
    const unsigned G = gridDim.x * gridDim.y * gridDim.z;
    unsigned sum, cnt, mine, sp = 0u;
    for (;;) {
        sum = 0u; cnt = 0u; mine = 0u;
#pragma unroll
        for (unsigned j = 0; j < 16; ++j) { const unsigned c = xb_ld(&bar[XB_XCNT(j)]); sum += c; cnt += (c > 0u) ? 1u : 0u; mine = (j == x) ? c : mine; }
        if (sum == G) break;
        __builtin_amdgcn_s_sleep(1);
        if ((++sp & 255u) == 0u) { if (xb_ld(&bar[XB_TMO])) break; if (sp > XB_SPIN_CAP) { atomicAdd(&bar[XB_TMO], 1u); break; } }
    }
    nloc = mine > 0u ? mine : 1u; nx = cnt > 0u ? cnt : 1u;
}
DI void xcd_barrier(const XcdBarrier& b) {
    asm volatile("s_waitcnt vmcnt(0)" ::: "memory");
    __syncthreads();
    if (threadIdx.x == 0) {
        unsigned* bar = b.bar;
        __builtin_amdgcn_s_waitcnt(0);
        unsigned nloc = b.st[0], nx = b.st[1];
        if (nloc == 0u) { xcd_barrier_complete(bar, b.x, nloc, nx); b.st[0] = nloc; b.st[1] = nx; }
        const unsigned old = xb_add(&bar[XB_XSUB(b.x)], 1u);
        const unsigned gen = old / nloc;
        if (old + 1u == (gen + 1u) * nloc) {
            __builtin_amdgcn_fence(__ATOMIC_RELEASE, "agent");
            asm volatile("s_waitcnt vmcnt(0)" ::: "memory");
            const unsigned og = xb_add(&bar[XB_TOP], 1u);
            const unsigned tg = og / nx;
            if (og + 1u == (tg + 1u) * nx) xb_add(&bar[XB_TOPGEN], 1u);
            else XB_SPIN(xb_ld(&bar[XB_TOPGEN]) == tg, bar);
            __builtin_amdgcn_fence(__ATOMIC_ACQUIRE, "agent");
            xb_add(&bar[XB_XGEN(b.x)], 1u);
            asm volatile("s_waitcnt vmcnt(0)" ::: "memory");
        } else {
            XB_SPIN(xb_ld(&bar[XB_XGEN(b.x)]) == gen, bar);
            __builtin_amdgcn_fence(__ATOMIC_ACQUIRE, "agent");
            asm volatile("s_waitcnt vmcnt(0)" ::: "memory");
        }
    }
    __syncthreads();
}

__global__ void __launch_bounds__(512, 2) mega(Params p_unused) {
    extern __shared__ __attribute__((aligned(16))) unsigned char lds_raw[];
    LAS unsigned char* lds = (LAS unsigned char*)lds_raw;
    cg::grid_group grid = cg::this_grid();
    #define RUN(k) (PRM.ph_lo <= (k) && (k) < PRM.ph_hi)
#define SEAM_ALWAYS() do { XcdBarrier xb_{(unsigned*)(LP(PRM.ws) + WS_BAR), xb_xcc_id(), (volatile LAS unsigned*)(lds + LDS_BYTES - 16)}; xcd_barrier(xb_); } while (0)
#define SEAM(k) do { if (PRM.coop && RUN(k) && RUN((k) + 1)) { XcdBarrier xb_{(unsigned*)(LP(PRM.ws) + WS_BAR), xb_xcc_id(), (volatile LAS unsigned*)(lds + LDS_BYTES - 16)}; xcd_barrier(xb_); } } while (0)
    if (PRM.coop == 2) grid.sync();
    { volatile LAS unsigned* stw = (volatile LAS unsigned*)(lds + LDS_BYTES - 16); if (threadIdx.x == 0) { stw[0] = 0u; stw[1] = 0u; } __syncthreads();
      if (PRM.coop) xcd_barrier_post((unsigned*)(LP(PRM.ws) + WS_BAR)); }
#if REPK == 20
    if (PRM.coop) for (int i = 0; i < 20; ++i) SEAM_ALWAYS();
#endif
    for (int l = 0; l < 2; ++l) {
        const int P = l * 10;
        const bool last = (l == 1);
        const float lam_init = 0.8f - 0.6f * __expf(-0.3f * (float)l);
#ifndef NO_PREP
        if (RUN(P + 0)) for (int rep = 0; rep < NREP(0); ++rep) phase_prep(lds, l);
#endif
        if (l == 0) SEAM(P + 0);
        if (RUN(P + 1)) for (int rep = 0; rep < NREP(1); ++rep) phase_norm(l, 0, false, l == 1 ? 2 : 0, 0, 5, l == 0 ? (const void*)PRM.in[I_X] : (const void*)PRM.out, l == 0 ? 0 : 1);
        SEAM(P + 1);
        if (RUN(P + 2)) for (int rep = 0; rep < NREP(2); ++rep) {
            pg8::Gemm g{(const bf16_t*)(LP(PRM.ws) + WS_A), (const bf16_t*)(LP(PRM.ws) + WS_WIN), DM, DM, DM};
            pg8::Order S; S.init(MROWS / 256, NIN / 256, GDIM(), BID(), 0);
            pg8::EpiBf16<0> E{(bf16_t*)(LP(PRM.ws) + WS_QB), 1024, 1};
            pg8::gemm_phase(lds, g, S, E);
        }
        SEAM(P + 2);
#ifndef NO_POST
        if (RUN(P + 3)) for (int rep = 0; rep < NREP(3); ++rep) phase_post(lds, l, rep == 0);
#endif
        SEAM(P + 3);
        if (RUN(P + 4)) {
            gla_scan();
#if REPK == 11
            if (l == 0) { SEAM_ALWAYS(); for (int u = BID(); u < NB * 4 * NCH; u += GDIM()) { const int c = u % NCH, h = (u / NCH) & 3, b = u / (4 * NCH); gla_g1_unit(lds, l, b, h, c); } SEAM_ALWAYS(); gla_scan(); }
#endif
#if REPK == 12
            if (l == 0) { SEAM_ALWAYS(); for (int u = BID(); u < NB * 4 * NCH; u += GDIM()) { const int c = u % NCH, h = (u / NCH) & 3, b = u / (4 * NCH); gla_g1_unit(lds, l, b, h, c); } SEAM_ALWAYS(); }
#endif
            for (int rep = 0; rep < NREP(4); ++rep) {
            {
                pg8::Gemm g{(const bf16_t*)(LP(PRM.ws) + WS_A1), (const bf16_t*)(LP(PRM.ws) + WS_UTL), 128, 128, 128};
                pg8::Order S; S.init(1, 256, GDIM(), BID(), 0);
                pg8::EpiDft1 E{(bf16_t*)(LP(PRM.ws) + WS_B2T)};
                pg8::gemm_phase(lds, g, S, E);
            }
            if (!last) {
                pg8::Gemm g{(const bf16_t*)(LP(PRM.ws) + WS_TCTX), (const bf16_t*)(LP(PRM.ws) + WS_UTC), 256, 256, 256};
                pg8::Order S; S.init(2, 4, 8, BID() - 116, 0);
                pg8::EpiDftCtx E{(bf16_t*)(LP(PRM.ws) + WS_PQ)};
                pg8::gemm_phase(lds, g, S, E);
            }
            __syncthreads();
            if (PRM.coop) SEAM_ALWAYS();
            {
                pg8::Gemm g{(const bf16_t*)(LP(PRM.ws) + WS_A2), (const bf16_t*)(LP(PRM.ws) + WS_B2T), 128, 128, 128};
                pg8::Order S; S.init(1, 512, GDIM(), BID(), 0);
                pg8::EpiDft2 E{(bf16_t*)(LP(PRM.ws) + WS_PQ)};
                pg8::gemm_phase(lds, g, S, E);
            }
            __syncthreads();
#ifndef NO_ATT
            {
                const float* qg = PRM.in[I_QG] + l * 64; const float* kgv = PRM.in[I_KG] + l * 64; const float* lp = PRM.in[I_LAM] + l * 256;
                float mq = 0.f, mk = 0.f, s01 = 0.f, s23 = 0.f;
                for (int i = 0; i < 64; ++i) { mq = fmaxf(mq, fabsf(qg[i])); mk = fmaxf(mk, fabsf(kgv[i])); s01 += lp[i] * lp[64 + i]; s23 += lp[128 + i] * lp[192 + i]; }
                const float shift2 = 8.f * mq * mk * LOG2E * 1.02f;
                const float lam = __builtin_bit_cast(float, __builtin_amdgcn_readfirstlane(__builtin_bit_cast(int, __expf(s01) - __expf(s23) + lam_init)));
                const int lam_init_bits = __builtin_amdgcn_readfirstlane(__builtin_bit_cast(int, lam_init));
                const int nun = last ? 512 : 528;
                const int G = GDIM(), bx = BID(); const int vcu = (G % 8 == 0) ? (bx % 8) * (G / 8) + bx / 8 : bx;
                for (int u = vcu; u < nun; u += G) {
                    int b, h, qt;
                    if (u < 512) { b = u >> 8; h = (u >> 5) & 7; qt = (u & 31) + 1; } else { const int v = u - 512; b = v >> 3; h = v & 7; qt = 0; }
                    att::attn_unit<false>(lds, (const bf16_t*)(LP(PRM.ws) + WS_QB), (const bf16_t*)(LP(PRM.ws) + WS_KB), (const bf16_t*)(LP(PRM.ws) + WS_VT), (bf16_t*)(LP(PRM.ws) + WS_A), b, h, qt, 0.f, lam, lam_init_bits, PRM.in[I_SUBLN] + l * 128);
                }
            }
#endif
            }
        }
        SEAM(P + 4);
        if (RUN(P + 5)) {
#ifndef NO_G3
            { const int G_ = GDIM(), bx_ = BID(); const int nlat = NB * 4 * 128;
              for (int u = bx_; ; u += G_) { int b, h, c;
                  if (u < nlat) { c = 4 + (u & 127); h = (u >> 7) & 3; b = u >> 9; }
                  else { const int v = bx_ - (G_ - 32); if (last || v < 0) break; c = v & 3; h = (v >> 2) & 3; b = (v >> 4) & 1; }
                  gla_g3_unit(lds, l, b, h, c);
                  if (u >= nlat) break; } }
#endif
            __syncthreads();
            {
                pg8::Gemm g{(const bf16_t*)(LP(PRM.ws) + WS_PQ), (const bf16_t*)(LP(PRM.ws) + WS_WCS), 1024, 1024, 1024};
                pg8::Order S; if (last) S.init(64, 2, GDIM(), BID(), 1); else S.init(66, 2, GDIM(), BID(), 0);
                pg8::EpiBf16<0> E{(bf16_t*)(LP(PRM.ws) + WS_A) + 1536, DM, 0};
                pg8::gemm_phase(lds, g, S, E);
            }
        }
        SEAM(P + 5);
        if (RUN(P + 6)) for (int rep = 0; rep < NREP(6); ++rep) {
            pg8::Gemm g{(const bf16_t*)(LP(PRM.ws) + WS_A), (const bf16_t*)(LP(PRM.ws) + WS_WOUT), DM, DM, DM};
            pg8::Order S; S.init(64, 8, GDIM(), BID(), 1);
            pg8::EpiResid E{l == 0 ? (const void*)PRM.in[I_X] : (const void*)PRM.out, l == 0 ? (void*)PRM.out : (void*)(LP(PRM.ws) + WS_KV), (const float*)(LP(PRM.ws) + WS_MOD) + (size_t)l * 3 * 12288 + 2 * DM, l == 0 ? 0 : 1, 1};
            pg8::gemm_phase(lds, g, S, E);
            if (!last) {
                pg8::Gemm g2{(const bf16_t*)(LP(PRM.ws) + WS_A), (const bf16_t*)(LP(PRM.ws) + WS_WOUT), DM / NSPLIT, DM, DM};
                pg8::Order S2; S2.init(2, 8, GDIM(), BID(), 2, NSPLIT, DM / NSPLIT);
                pg8::EpiPartial E2{(float*)(LP(PRM.ws) + WS_PART), DM / NSPLIT};
                pg8::gemm_phase(lds, g2, S2, E2);
            }
        }
        SEAM(P + 6);
        if (RUN(P + 7)) phase_norm(l, 1, last, last ? 0 : 1, l, 2, l == 0 ? (const void*)PRM.out : (const void*)(LP(PRM.ws) + WS_KV), 1);
        SEAM(P + 7);
        if (RUN(P + 8)) for (int rep = 0; rep < NREP(8); ++rep) {
            pg8::Gemm g{(const bf16_t*)(LP(PRM.ws) + WS_A), (const bf16_t*)(LP(PRM.ws) + WS_WFF1), DM, DM, DM};
            pg8::Order S; if (last) S.init(64, 32, GDIM(), BID(), 1); else S.init(66, 32, GDIM(), BID(), 0);
            pg8::EpiBf16<1> E{(bf16_t*)(LP(PRM.ws) + WS_H), DFF, 0};
            pg8::gemm_phase(lds, g, S, E);
        }
        SEAM(P + 8);
        if (RUN(P + 9)) {
            pg8::Gemm g{(const bf16_t*)(LP(PRM.ws) + WS_H), (const bf16_t*)(LP(PRM.ws) + WS_WFF2), DFF, DFF, DFF};
            pg8::Order S; S.init(64, 8, GDIM(), BID(), 1);
            pg8::EpiResid E{l == 0 ? (const void*)PRM.out : (const void*)(LP(PRM.ws) + WS_KV), (void*)PRM.out, (const float*)(LP(PRM.ws) + WS_MOD) + (size_t)l * 3 * 12288 + 5 * DM, 1, l == 0 ? 1 : 0};
            pg8::gemm_phase(lds, g, S, E);
            if (NREP(9) == 2) {
                pg8::Gemm g3{(const bf16_t*)(LP(PRM.ws) + WS_H), (const bf16_t*)(LP(PRM.ws) + WS_WFF2), DFF, DFF, DFF};
                pg8::Order S3; S3.init(64, 8, GDIM(), BID(), 1);
                pg8::EpiBf16<0> E3{(bf16_t*)(LP(PRM.ws) + WS_T + ((size_t)64 << 20)), DM, 0};
                pg8::gemm_phase(lds, g3, S3, E3);
            }
            if (!last) {
                pg8::Gemm g2{(const bf16_t*)(LP(PRM.ws) + WS_H), (const bf16_t*)(LP(PRM.ws) + WS_WFF2), DFF / NSPLIT, DFF, DFF};
                pg8::Order S2; S2.init(2, 8, GDIM(), BID(), 2, NSPLIT, DFF / NSPLIT);
                pg8::EpiPartial E2{(float*)(LP(PRM.ws) + WS_PART), DFF / NSPLIT};
                pg8::gemm_phase(lds, g2, S2, E2);
            }
        }
        SEAM(P + 9);
    }
}

extern "C" void kernel_launch(void* const* d_in, const int* in_sizes, int n_in, void* d_out, int out_size, void* d_ws, size_t ws_size, hipStream_t stream) {
    static int grid = 0;
    if (grid == 0) {
        if (n_in != 20 || out_size != NB * SEQ * DM || ws_size < WS_END) { fprintf(stderr, "kernel_launch: unexpected problem (n_in %d out %d ws %zu need %zu)\n", n_in, out_size, ws_size, (size_t)WS_END); grid = -1; return; }
        int dev = 0, cus = 0, per_cu = 0;
        hipGetDevice(&dev); hipDeviceGetAttribute(&cus, hipDeviceAttributeMultiprocessorCount, dev);
        if (hipFuncSetAttribute((const void*)mega, hipFuncAttributeMaxDynamicSharedMemorySize, LDS_BYTES) != hipSuccess) { fprintf(stderr, "kernel_launch: hipFuncSetAttribute failed\n"); grid = -1; return; }
        if (hipOccupancyMaxActiveBlocksPerMultiprocessor(&per_cu, (const void*)mega, 512, LDS_BYTES) != hipSuccess || per_cu < 1) { fprintf(stderr, "kernel_launch: occupancy query says %d\n", per_cu); per_cu = 1; }
        (void)hipGetLastError();
        grid = cus;
    }
    if (grid < 0) return;
    Params p{};
    for (int i = 0; i < 20; ++i) p.in[i] = (const float*)d_in[i];
    p.out = (float*)d_out; p.ws = (unsigned char*)d_ws; p.ph_lo = 0; p.ph_hi = 20; p.coop = 1; p.pad = 0;
    if (hipMemsetAsync((char*)d_ws + WS_BAR, 0, 16384, stream) != hipSuccess) { fprintf(stderr, "kernel_launch: memset of barrier words failed\n"); return; }
    void* args[] = {&p};
    hipError_t e = hipLaunchCooperativeKernel((const void*)mega, dim3(grid), dim3(512), args, LDS_BYTES, stream);
    if (e != hipSuccess) fprintf(stderr, "cooperative launch failed: %s (grid %d)\n", hipGetErrorString(e), grid);
}
```
